# Optimizing an MI355X kernel written in HIP

```python
import jax
import jax.numpy as jnp
from jax import lax
import numpy as np

D_MODEL = 1024
BATCH = 2
SEQ = 8192
DEPTH = 4

GRID_W = 64
CTX_LEN = 256
HEAD_DIM = 128
A_Q_HEADS = 4
A_KV_HEADS = 2
B_Q_HEADS = 4
B_KV_HEADS = 2
A_GROUP = A_Q_HEADS // A_KV_HEADS
B_GROUP = B_Q_HEADS // B_KV_HEADS
A_QW = A_Q_HEADS * HEAD_DIM
A_KVW = A_KV_HEADS * HEAD_DIM
B_QW = B_Q_HEADS * HEAD_DIM
B_KVW = B_KV_HEADS * HEAD_DIM
ATTN_SECTIONS = (A_QW, A_KVW, A_KVW, B_QW, B_KVW, B_KVW)
ATTN_IN = A_QW + 2 * A_KVW + B_QW + 2 * B_KVW
ATTN_MIX = A_QW + B_QW
ATTN_SCALE = HEAD_DIM ** -0.5
Q_BLOCK = 128
WINDOW = 128
ROPE_THETA = 10000.0
ROPE_AXIS_DIM = HEAD_DIM // 2
GLA_HEADS = 4
GLA_KEY_DIM = D_MODEL // 2
GLA_VAL_DIM = D_MODEL
GLA_DK = GLA_KEY_DIM // GLA_HEADS
GLA_DV = GLA_VAL_DIM // GLA_HEADS
GLA_IN = 2 * GLA_KEY_DIM + 2 * GLA_VAL_DIM
GLA_GATE_RANK = 16
GLA_GATE_NORM = 16.0
GLA_CHUNK = 64
D_FF = 2816
CONV_W = 3
N_ATTN_LAYERS = (DEPTH + 1) // 2
N_GLA_LAYERS = DEPTH // 2
DEEPNORM_ALPHA = (2 * DEPTH) ** 0.25
DEEPNORM_BETA = (8 * DEPTH) ** -0.25
EPS = 1e-6

kernel_name = 'hybrid_diffusion_trunk'


def layer_norm(x, g, b):
    xf = x.astype(jnp.float32)
    mu = jnp.mean(xf, axis=-1, keepdims=True)
    var = jnp.mean(jnp.square(xf - mu), axis=-1, keepdims=True)
    return ((xf - mu) * lax.rsqrt(var + EPS) * g + b).astype(x.dtype)


def rms_norm(x, g):
    xf = x.astype(jnp.float32)
    return (xf * lax.rsqrt(jnp.mean(jnp.square(xf), axis=-1, keepdims=True) + EPS) * g).astype(x.dtype)


def to_heads(z, n_heads, head_dim):
    b, t, _ = z.shape
    return z.reshape(b, t, n_heads, head_dim).transpose(0, 2, 1, 3)


def from_heads(z):
    b, h, t, d = z.shape
    return z.transpose(0, 2, 1, 3).reshape(b, t, h * d)


def merge_groups(o):
    b, hk, g, t, d = o.shape
    return from_heads(o.reshape(b, hk * g, t, d))


def axial_rope_tables(rows):
    row = jnp.repeat(jnp.arange(rows, dtype=jnp.float32), GRID_W)
    col = jnp.tile(jnp.arange(GRID_W, dtype=jnp.float32), rows)
    inv_freq = jnp.power(ROPE_THETA, -jnp.arange(ROPE_AXIS_DIM // 2, dtype=jnp.float32) * 2.0 / ROPE_AXIS_DIM)
    ang = jnp.concatenate([row[:, None] * inv_freq, col[:, None] * inv_freq], axis=-1)
    return jnp.cos(ang), jnp.sin(ang)


def apply_rope(z, cos, sin):
    zf = z.astype(jnp.float32)
    z1, z2 = zf[..., :HEAD_DIM // 2], zf[..., HEAD_DIM // 2:]
    return jnp.concatenate([z1 * cos - z2 * sin, z1 * sin + z2 * cos], axis=-1).astype(z.dtype)


def scores(q, k):
    return jnp.einsum('bhgqd,bhkd->bhgqk', q, k).astype(jnp.float32) * ATTN_SCALE


def ada_modulation(cond, w, b):
    return jnp.split(jax.nn.silu(cond) @ w + b, 6, axis=-1)


def attn_project(h, w_in, q_norm, k_norm, rope):
    p = h @ w_in
    parts, off = [], 0
    for width in ATTN_SECTIONS:
        parts.append(p[..., off:off + width])
        off += width
    aq, ak, av, bq, bk, bv = parts
    aq = rms_norm(to_heads(aq, A_Q_HEADS, HEAD_DIM), q_norm)
    ak = rms_norm(to_heads(ak, A_KV_HEADS, HEAD_DIM), k_norm)
    av = to_heads(av, A_KV_HEADS, HEAD_DIM)
    bq = to_heads(bq, B_Q_HEADS, HEAD_DIM)
    bk = to_heads(bk, B_KV_HEADS, HEAD_DIM)
    bv = to_heads(bv, B_KV_HEADS, HEAD_DIM)
    if rope is not None:
        cos, sin = rope
        aq, ak, bq, bk = [apply_rope(z, cos, sin) for z in (aq, ak, bq, bk)]
    b, _, t, _ = aq.shape
    aq = aq.reshape(b, A_KV_HEADS, A_GROUP, t, HEAD_DIM)
    bq = bq.reshape(b, B_KV_HEADS, B_GROUP, t, HEAD_DIM)
    return aq, ak, av, bq, bk, bv


def dense_attention(q, k, v):
    p = jax.nn.softmax(scores(q, k), axis=-1)
    return jnp.einsum('bhgqk,bhkd->bhgqd', p.astype(v.dtype), v)


def global_attention_latent(q, k_lat, v_lat, k_ctx, v_ctx):
    b, hk, g, n, d = q.shape
    nb = n // Q_BLOCK
    k_all = jnp.concatenate([k_lat, k_ctx], axis=2)
    v_all = jnp.concatenate([v_lat, v_ctx], axis=2)
    q_blocks = jnp.moveaxis(q.reshape(b, hk, g, nb, Q_BLOCK, d), 3, 0)
    o = lax.map(lambda qb: dense_attention(qb, k_all, v_all), q_blocks)
    return jnp.moveaxis(o, 0, 3).reshape(b, hk, g, n, d)


def window_attention_latent(q, k_lat, v_lat, k_ctx, v_ctx, sink):
    b, hk, g, n, d = q.shape
    nb = n // Q_BLOCK

    def bands(z):
        zp = jnp.pad(z, ((0, 0), (0, 0), (Q_BLOCK, Q_BLOCK), (0, 0))).reshape(b, hk, nb + 2, Q_BLOCK, d)
        return jnp.concatenate([zp[:, :, :-2], zp[:, :, 1:-1], zp[:, :, 2:]], axis=3)

    kb, vb = bands(k_lat), bands(v_lat)
    qb = q.reshape(b, hk, g, nb, Q_BLOCK, d)
    s_band = jnp.einsum('bhgnqd,bhnkd->bhgnqk', qb, kb).astype(jnp.float32) * ATTN_SCALE
    q_pos = jnp.arange(nb)[:, None, None] * Q_BLOCK + jnp.arange(Q_BLOCK)[None, :, None]
    k_pos = jnp.arange(nb)[:, None, None] * Q_BLOCK - Q_BLOCK + jnp.arange(3 * Q_BLOCK)[None, None, :]
    valid = (jnp.abs(k_pos - q_pos) <= WINDOW) & (k_pos >= 0) & (k_pos < n)
    s_band = jnp.where(valid, s_band, -jnp.inf)
    s_ctx = jnp.einsum('bhgnqd,bhcd->bhgnqc', qb, k_ctx).astype(jnp.float32) * ATTN_SCALE
    s_sink = jnp.broadcast_to(sink.astype(jnp.float32).reshape(1, hk, g, 1, 1, 1), s_ctx.shape[:-1] + (1,))
    p = jax.nn.softmax(jnp.concatenate([s_band, s_ctx, s_sink], axis=-1), axis=-1).astype(v_lat.dtype)
    n_band = 3 * Q_BLOCK
    n_ctx = k_ctx.shape[2]
    o = (jnp.einsum('bhgnqk,bhnkd->bhgnqd', p[..., :n_band], vb)
         + jnp.einsum('bhgnqc,bhcd->bhgnqd', p[..., n_band:n_band + n_ctx], v_ctx))
    return o.reshape(b, hk, g, n, d)


def sink_attention_context(q, k, v, sink):
    b, hk, g, t, d = q.shape
    s = scores(q, k)
    s_sink = jnp.broadcast_to(sink.astype(jnp.float32).reshape(1, hk, g, 1, 1), (b, hk, g, t, 1))
    p = jax.nn.softmax(jnp.concatenate([s, s_sink], axis=-1), axis=-1)[..., :-1]
    return jnp.einsum('bhgqk,bhkd->bhgqd', p.astype(v.dtype), v)


def attn_mixer(h_lat, h_ctx, w_in, q_norm, k_norm, sink, w_out, rope, need_ctx):
    aq, ak, av, bq, bk, bv = attn_project(h_lat, w_in, q_norm, k_norm, rope)
    caq, cak, cav, cbq, cbk, cbv = attn_project(h_ctx, w_in, q_norm, k_norm, None)
    o_a = global_attention_latent(aq, ak, av, cak, cav)
    o_b = window_attention_latent(bq, bk, bv, cbk, cbv, sink)
    y_lat = jnp.concatenate([merge_groups(o_a), merge_groups(o_b)], axis=-1) @ w_out
    y_ctx = None
    if need_ctx:
        co_a = dense_attention(caq, cak, cav)
        co_b = sink_attention_context(cbq, cbk, cbv, sink)
        y_ctx = jnp.concatenate([merge_groups(co_a), merge_groups(co_b)], axis=-1) @ w_out
    return y_lat, y_ctx


def gla_project(h, w_in, w_a1, w_a2, b_a):
    b, t, _ = h.shape
    p = h @ w_in
    q = p[..., :GLA_KEY_DIM]
    k = p[..., GLA_KEY_DIM:2 * GLA_KEY_DIM]
    v = p[..., 2 * GLA_KEY_DIM:2 * GLA_KEY_DIM + GLA_VAL_DIM]
    g = p[..., 2 * GLA_KEY_DIM + GLA_VAL_DIM:]
    q = to_heads(q, GLA_HEADS, GLA_DK) * (GLA_DK ** -0.5)
    k = to_heads(k, GLA_HEADS, GLA_DK)
    v = to_heads(v, GLA_HEADS, GLA_DV)
    low = jnp.einsum('btd,zdr->zbtr', h, w_a1)
    logits = jnp.einsum('zbtr,zrk->zbtk', low, w_a2) + b_a[:, None, None, :]
    log_decay = jax.nn.log_sigmoid(logits.astype(jnp.float32)) / GLA_GATE_NORM
    log_decay = log_decay.reshape(2, b, t, GLA_HEADS, GLA_DK).transpose(0, 1, 3, 2, 4)
    return q, k, v, g, log_decay


def gla_chunk_scan(q, k, v, log_decay, s0):
    b, h, t, dk = q.shape
    dv = v.shape[-1]
    nc = t // GLA_CHUNK

    def chunks(z):
        return jnp.moveaxis(z.astype(jnp.float32).reshape(b, h, nc, GLA_CHUNK, z.shape[-1]), 2, 0)

    lower = jnp.tril(jnp.ones((GLA_CHUNK, GLA_CHUNK), dtype=bool))[:, :, None]

    def step(state, inp):
        qc, kc, vc, lc = inp
        cum = jnp.cumsum(lc, axis=2)
        rel = jnp.where(lower, cum[:, :, :, None, :] - cum[:, :, None, :, :], -jnp.inf)
        attn = jnp.einsum('bhtd,bhsd,bhtsd->bhts', qc, kc, jnp.exp(rel))
        last = cum[:, :, -1:, :]
        out = attn @ vc + jnp.einsum('bhtd,bhdv->bhtv', qc * jnp.exp(cum), state)
        state = (jnp.exp(last[:, :, 0, :, None]) * state
                 + jnp.einsum('bhsd,bhsv->bhdv', kc * jnp.exp(last - cum), vc))
        return state, out

    s_fin, out = lax.scan(step, s0.astype(jnp.float32), (chunks(q), chunks(k), chunks(v), chunks(log_decay)))
    out = jnp.moveaxis(out, 0, 2).reshape(b, h, t, dv)
    return out.astype(v.dtype), s_fin


def gla_output(o, g, head_norm, w_out):
    o = from_heads(rms_norm(o, head_norm))
    return (o * jax.nn.silu(g)) @ w_out


def gla_mixer(h_lat, h_ctx, w_in, w_a1, w_a2, b_a, head_norm, w_out, need_ctx):
    flip = lambda z: jnp.flip(z, axis=2)
    q, k, v, g, ld = gla_project(h_lat, w_in, w_a1, w_a2, b_a)
    cq, ck, cv, cg, cld = gla_project(h_ctx, w_in, w_a1, w_a2, b_a)
    s0 = jnp.zeros((q.shape[0], GLA_HEADS, GLA_DK, GLA_DV), jnp.float32)
    co_f, cs_f = gla_chunk_scan(cq, ck, cv, cld[0], s0)
    co_b, cs_b = gla_chunk_scan(flip(cq), flip(ck), flip(cv), flip(cld[1]), s0)
    o_f, _ = gla_chunk_scan(q, k, v, ld[0], cs_f)
    o_b, _ = gla_chunk_scan(flip(q), flip(k), flip(v), flip(ld[1]), cs_b)
    y_lat = gla_output(o_f + flip(o_b), g, head_norm, w_out)
    y_ctx = None
    if need_ctx:
        y_ctx = gla_output(co_f + flip(co_b), cg, head_norm, w_out)
    return y_lat, y_ctx


def conv_ffn(h, w_up, conv_w, conv_b, w_down):
    t = h.shape[1]
    u = h @ w_up
    half = CONV_W // 2
    up = jnp.pad(u, ((0, 0), (half, half), (0, 0)))
    acc = conv_b + conv_w[0] * up[:, 0:t]
    for j in range(1, CONV_W):
        acc = acc + conv_w[j] * up[:, j:j + t]
    gate, val = jnp.split(acc, 2, axis=-1)
    return (jax.nn.silu(gate) * val) @ w_down


def setup_inputs(seed: int = 0) -> dict:
    key = jax.random.key(seed)
    ks = jax.random.split(key, 23)

    def nrm(k, shape, scale):
        return jax.random.normal(k, shape, jnp.float32) * scale

    d, f = D_MODEL, D_FF
    na, ng = N_ATTN_LAYERS, N_GLA_LAYERS
    return {
        'x': nrm(ks[0], (BATCH, SEQ, d), 1.0),
        'c': nrm(ks[1], (BATCH, d), 1.0),
        'ctx': nrm(ks[2], (BATCH, CTX_LEN, d), 1.0),
        'c_ctx': nrm(ks[3], (d,), 1.0),
        'ada_w': nrm(ks[4], (DEPTH, d, 6 * d), 0.5 * d ** -0.5),
        'ada_b': nrm(ks[5], (DEPTH, 6 * d), 0.01),
        'ln_g': 1.0 + nrm(ks[6], (DEPTH, 2, d), 0.02),
        'ln_b': nrm(ks[7], (DEPTH, 2, d), 0.02),
        'ffn_w_up': nrm(ks[8], (DEPTH, d, 2 * f), d ** -0.5),
        'ffn_conv_w': nrm(ks[9], (DEPTH, CONV_W, 2 * f), CONV_W ** -0.5),
        'ffn_conv_b': nrm(ks[10], (DEPTH, 2 * f), 0.01),
        'ffn_w_down': nrm(ks[11], (DEPTH, f, d), DEEPNORM_BETA * f ** -0.5),
        'attn_w_in': nrm(ks[12], (na, d, ATTN_IN), d ** -0.5),
        'attn_q_norm': 1.0 + nrm(ks[13], (na, HEAD_DIM), 0.02),
        'attn_k_norm': 1.0 + nrm(ks[14], (na, HEAD_DIM), 0.02),
        'attn_sink': nrm(ks[15], (na, B_Q_HEADS), 0.5),
        'attn_w_out': nrm(ks[16], (na, ATTN_MIX, d), DEEPNORM_BETA * ATTN_MIX ** -0.5),
        'gla_w_in': nrm(ks[17], (ng, d, GLA_IN), d ** -0.5),
        'gla_w_a1': nrm(ks[18], (ng, 2, d, GLA_GATE_RANK), d ** -0.5),
        'gla_w_a2': nrm(ks[19], (ng, 2, GLA_GATE_RANK, GLA_KEY_DIM), GLA_GATE_RANK ** -0.5),
        'gla_b_a': 1.0 + nrm(ks[20], (ng, 2, GLA_KEY_DIM), 0.5),
        'gla_head_norm': 1.0 + nrm(ks[21], (ng, GLA_DV), 0.02),
        'gla_w_out': nrm(ks[22], (ng, GLA_VAL_DIM, d), DEEPNORM_BETA * GLA_VAL_DIM ** -0.5),
    }


def reference(x, c, ctx, c_ctx, ada_w, ada_b, ln_g, ln_b, ffn_w_up, ffn_conv_w, ffn_conv_b, ffn_w_down,
              attn_w_in, attn_q_norm, attn_k_norm, attn_sink, attn_w_out,
              gla_w_in, gla_w_a1, gla_w_a2, gla_b_a, gla_head_norm, gla_w_out):
    rows = x.shape[1] // GRID_W
    rope = axial_rope_tables(rows)
    h, hc = x, ctx
    for i in range(DEPTH):
        need_ctx = i < DEPTH - 1
        sh1, sc1, g1, sh2, sc2, g2 = [m[:, None, :] for m in ada_modulation(c, ada_w[i], ada_b[i])]
        csh1, csc1, cg1, csh2, csc2, cg2 = ada_modulation(c_ctx, ada_w[i], ada_b[i])
        a_lat = h * (1 + sc1) + sh1
        a_ctx = hc * (1 + csc1) + csh1
        j = i // 2
        if i % 2 == 0:
            y, yc = attn_mixer(a_lat, a_ctx, attn_w_in[j], attn_q_norm[j], attn_k_norm[j], attn_sink[j],
                               attn_w_out[j], rope, need_ctx)
        else:
            y, yc = gla_mixer(a_lat, a_ctx, gla_w_in[j], gla_w_a1[j], gla_w_a2[j], gla_b_a[j],
                              gla_head_norm[j], gla_w_out[j], need_ctx)
        h = layer_norm(DEEPNORM_ALPHA * h + g1 * y, ln_g[i, 0], ln_b[i, 0])
        f = conv_ffn(h * (1 + sc2) + sh2, ffn_w_up[i], ffn_conv_w[i], ffn_conv_b[i], ffn_w_down[i])
        h = layer_norm(DEEPNORM_ALPHA * h + g2 * f, ln_g[i, 1], ln_b[i, 1])
        if need_ctx:
            hc = layer_norm(DEEPNORM_ALPHA * hc + cg1 * yc, ln_g[i, 0], ln_b[i, 0])
            fc = conv_ffn(hc * (1 + csc2) + csh2, ffn_w_up[i], ffn_conv_w[i], ffn_conv_b[i], ffn_w_down[i])
            hc = layer_norm(DEEPNORM_ALPHA * hc + cg2 * fc, ln_g[i, 1], ln_b[i, 1])
    return h
```

```cpp
#include <hip/hip_runtime.h>
#include <hip/hip_cooperative_groups.h>
#include <cstdio>
#include <cstdint>
namespace cg = cooperative_groups;

#ifndef PROBE_KIND
#define PROBE_KIND -1
#endif
#ifndef SINGLE_LAUNCH
#define SINGLE_LAUNCH 1
#endif

#define DI __device__ __forceinline__
typedef unsigned short bf16;
typedef short bf16x8 __attribute__((ext_vector_type(8)));
typedef short s16x4 __attribute__((ext_vector_type(4)));
typedef float f32x16 __attribute__((ext_vector_type(16)));
typedef float f32x4 __attribute__((ext_vector_type(4)));
typedef unsigned u32x4 __attribute__((ext_vector_type(4)));
typedef unsigned u32x2 __attribute__((ext_vector_type(2)));

#define MFMA32(a, b, c) __builtin_amdgcn_mfma_f32_32x32x16_bf16((a), (b), (c), 0, 0, 0)
#define MFMA16(a, b, c) __builtin_amdgcn_mfma_f32_16x16x32_bf16((a), (b), (c), 0, 0, 0)

constexpr int TL = 16384, TA = 16896, DM = 1024, DFF = 2816;
constexpr int VTLD = 8448;
constexpr float ALPHA = 1.681792830507429f;
constexpr float EPS = 1e-6f;
constexpr int NTHREADS = 256;
constexpr int LDS_BYTES = 73728;

constexpr size_t OFF_H = 0;
constexpr size_t OFF_ABF = OFF_H + (size_t)TA * 1024 * 4;
constexpr size_t OFF_WTS = OFF_ABF + (size_t)TA * 1024 * 2;
constexpr size_t W_IN = 0, W_OUT = 3276800, W_UP = 4325376, W_DOWN = 10092544, W_END = 12976128;
constexpr size_t OFF_MOD = OFF_WTS + W_END * 2;
constexpr size_t OFF_COS = OFF_MOD + 4 * 3 * 6144 * 4;
constexpr size_t OFF_SIN = OFF_COS + 8192 * 64 * 4;
constexpr size_t OFF_SCR = OFF_SIN + 8192 * 64 * 4;
constexpr size_t S_Y = OFF_SCR;
constexpr size_t S_QK = S_Y;
constexpr size_t S_VT = S_QK + (size_t)TA * 1536 * 2;
constexpr size_t S_QH = S_Y;
constexpr size_t S_OI = S_QH + (size_t)TA * 1024 * 2;
constexpr size_t S_A2 = S_Y + (size_t)TA * 1024 * 4;
constexpr size_t S_QKR = S_A2;
constexpr size_t S_VTG = S_QKR + (size_t)TA * 1024 * 2;
constexpr size_t S_LOW = S_VTG + (size_t)TA * 1024 * 2;
constexpr size_t S_EXPL = S_LOW + (size_t)TA * 32 * 4;
constexpr size_t S_SLOC = S_EXPL + 2 * 264 * 512 * 4;
constexpr size_t S_DSEG = S_SLOC + (size_t)64 * 8 * 8192 * 4;
constexpr size_t S_MIX = S_A2 + (size_t)TA * 2816 * 2;
constexpr size_t S_OB = S_MIX + (size_t)TA * 1024 * 2;
constexpr size_t OFF_BAR = S_OB + (size_t)TA * 1024 * 2;
constexpr size_t OFF_ZERO = OFF_BAR + 16384;
constexpr size_t WS_END = OFF_ZERO + 8192;
static_assert(S_DSEG + 64 * 8 * 128 * 4 <= S_MIX, "gla scratch overflow");

struct Params {
    const float *x, *c, *ctx, *c_ctx, *ada_w, *ada_b, *ln_g, *ln_b, *up_w, *conv_w, *conv_b, *down_w;
    const float *a_win, *a_qn, *a_kn, *a_sink, *a_wout, *g_win, *g_wa1, *g_wa2, *g_ba, *g_hn, *g_wout;
    float* out;
    unsigned char* ws;
};

DI int tidx() { int t = __builtin_amdgcn_workitem_id_x(); asm volatile("" : "+v"(t)); return t; }
typedef float f32x2 __attribute__((ext_vector_type(2)));
typedef __bf16 hbf16x2 __attribute__((ext_vector_type(2)));
DI unsigned pack2(float a, float b) { f32x2 v = {a, b}; return __builtin_bit_cast(unsigned, __builtin_convertvector(v, hbf16x2)); }
DI bf16 f2bf(float x) { return (bf16)(pack2(x, 0.f) & 0xffffu); }
DI float bf2f(bf16 b) { return __uint_as_float(((unsigned)b) << 16); }
DI bf16x8 pack8(float a0, float a1, float a2, float a3, float a4, float a5, float a6, float a7) {
    u32x4 p; p.x = pack2(a0, a1); p.y = pack2(a2, a3); p.z = pack2(a4, a5); p.w = pack2(a6, a7);
    return __builtin_bit_cast(bf16x8, p);
}
DI bf16x8 join4(s16x4 lo, s16x4 hi) { bf16x8 r; r[0] = lo[0]; r[1] = lo[1]; r[2] = lo[2]; r[3] = lo[3]; r[4] = hi[0]; r[5] = hi[1]; r[6] = hi[2]; r[7] = hi[3]; return r; }
DI float wave_sum(float v) {
#pragma unroll
    for (int o = 32; o > 0; o >>= 1) v += __shfl_xor(v, o);
    return v;
}
DI float silu(float x) { return x / (1.f + __expf(-x)); }


#define XB_TMO      128
#define XB_XCNT(j)  (256  + 64 * (j))
#define XB_XSUB(j)  (1280 + 64 * (j))
#define XB_XGEN(j)  (2304 + 64 * (j))
#define XB_TOP      3328
#define XB_TOPGEN   3392
#define XCD_BAR_WORDS 3456
#define XB_SPIN_CAP (1u << 22)
#define LAS __attribute__((address_space(3)))
DI unsigned xb_ld(unsigned* p) { return __hip_atomic_load(p, __ATOMIC_RELAXED, __HIP_MEMORY_SCOPE_AGENT); }
DI unsigned xb_add(unsigned* p, unsigned v) { return __hip_atomic_fetch_add(p, v, __ATOMIC_RELAXED, __HIP_MEMORY_SCOPE_AGENT); }
DI unsigned xb_xcc_id() { return (unsigned)__builtin_amdgcn_s_getreg((3 << 11) | 20) & 0xFu; }
#define XB_SPIN(cond, bar) do { unsigned _sp = 0; while (cond) { __builtin_amdgcn_s_sleep(1); \
    if ((++_sp & 255u) == 0u) { if (xb_ld(&(bar)[XB_TMO])) break; if (_sp > XB_SPIN_CAP) { atomicAdd(&(bar)[XB_TMO], 1u); break; } } } } while (0)
struct XcdBarrier { unsigned* bar; unsigned x; volatile LAS unsigned* st; };
DI XcdBarrier xcd_barrier_post(unsigned* bar, volatile LAS unsigned* st) {
    XcdBarrier b; b.bar = bar; b.x = xb_xcc_id(); b.st = st;
    if (__builtin_amdgcn_workitem_id_x() == 0) (void)xb_add(&bar[XB_XCNT(b.x)], 1u);
    return b;
}
DI void xcd_barrier_complete(unsigned* bar, unsigned x, unsigned& nloc, unsigned& nx) {
    const unsigned G = gridDim.x;
    unsigned sum, cnt, mine, sp = 0u;
    for (;;) {
        sum = 0u; cnt = 0u; mine = 0u;
#pragma unroll
        for (unsigned j = 0; j < 16; ++j) { const unsigned c = xb_ld(&bar[XB_XCNT(j)]); sum += c; cnt += (c > 0u) ? 1u : 0u; mine = (j == x) ? c : mine; }
        if (sum == G) break;
        __builtin_amdgcn_s_sleep(1);
        if ((++sp & 255u) == 0u) { if (xb_ld(&bar[XB_TMO])) break; if (sp > XB_SPIN_CAP) { atomicAdd(&bar[XB_TMO], 1u); break; } }
    }
    nloc = mine > 0u ? mine : 1u; nx = cnt > 0u ? cnt : 1u;
}
DI void xcd_barrier(const XcdBarrier& b) {
    asm volatile("s_waitcnt vmcnt(0)" ::: "memory");
    __syncthreads();
    if (__builtin_amdgcn_workitem_id_x() == 0) {
        unsigned* bar = b.bar;
        __builtin_amdgcn_s_waitcnt(0);
        unsigned nloc = b.st[0], nx = b.st[1];
        if (nloc == 0u) { xcd_barrier_complete(bar, b.x, nloc, nx); b.st[0] = nloc; b.st[1] = nx; }
        const unsigned old = xb_add(&bar[XB_XSUB(b.x)], 1u);
        const unsigned gen = old / nloc;
        if (old + 1u == (gen + 1u) * nloc) {
            __builtin_amdgcn_fence(__ATOMIC_RELEASE, "agent");
            asm volatile("s_waitcnt vmcnt(0)" ::: "memory");
            const unsigned og = xb_add(&bar[XB_TOP], 1u);
            const unsigned tg = og / nx;
            if (og + 1u == (tg + 1u) * nx) xb_add(&bar[XB_TOPGEN], 1u);
            else XB_SPIN(xb_ld(&bar[XB_TOPGEN]) == tg, bar);
            __builtin_amdgcn_fence(__ATOMIC_ACQUIRE, "agent");
            xb_add(&bar[XB_XGEN(b.x)], 1u);
            asm volatile("s_waitcnt vmcnt(0)" ::: "memory");
        } else {
            XB_SPIN(xb_ld(&bar[XB_XGEN(b.x)]) == gen, bar);
            __builtin_amdgcn_fence(__ATOMIC_ACQUIRE, "agent");
            asm volatile("s_waitcnt vmcnt(0)" ::: "memory");
        }
    }
    __syncthreads();
}

constexpr int LDS_LD = 72;
struct ARowPlain { const bf16* base; int ld; DI const bf16* operator()(int r) const { return base + (size_t)r * ld; } };
struct ARowHalo { const bf16* base; int ld, pos0, len;
    DI const bf16* operator()(int r) const { int pp = pos0 + r; return (pp >= 0 && pp < len) ? base + (size_t)pp * ld : nullptr; } };

#define RAW_BARRIER() do { asm volatile("s_waitcnt lgkmcnt(0)" ::: "memory"); __builtin_amdgcn_s_barrier(); } while (0)
template <class AR>
DI void gemm_tile(const AR& ar, const bf16* __restrict__ Bt, int ldb, int K, f32x16 (&acc)[2][2], unsigned char* lds, const bf16* zbuf) {
    const int tid = tidx(), lane = tid & 63, w = tid >> 6, wm = w >> 1, wn = w & 1, l32 = lane & 31, hh = lane >> 5;
    const bf16* ap[4]; const bf16* bp[4];
#pragma unroll
    for (int i = 0; i < 4; ++i) {
        const int r = 32 * w + 8 * i + (lane >> 3), lc = (lane & 7) ^ ((r >> 1) & 7);
        const bf16* a = ar(r); ap[i] = (a ? a : zbuf) + lc * 8; bp[i] = Bt + (size_t)r * ldb + lc * 8;
    }
#pragma unroll
    for (int mi = 0; mi < 2; ++mi)
#pragma unroll
        for (int ni = 0; ni < 2; ++ni)
#pragma unroll
            for (int i = 0; i < 16; ++i) acc[mi][ni][i] = 0.f;
    const int wbase = w * 4096;
#define GEMM_ISSUE(stage, k0)                                                                                   \
    do {                                                                                                        \
        _Pragma("unroll") for (int i = 0; i < 4; ++i) {                                                         \
            __builtin_amdgcn_global_load_lds((const unsigned*)(ap[i] + (k0)), (LAS unsigned*)(lds + (stage) * 32768 + wbase + i * 1024), 16, 0, 0);          \
            __builtin_amdgcn_global_load_lds((const unsigned*)(bp[i] + (k0)), (LAS unsigned*)(lds + (stage) * 32768 + 16384 + wbase + i * 1024), 16, 0, 0);  \
        }                                                                                                       \
    } while (0)
    const int nk = K >> 6;
    const int key = (l32 >> 1) & 7;
    GEMM_ISSUE(0, 0);
    for (int j = 0; j < nk; ++j) {
        asm volatile("s_waitcnt vmcnt(0)" ::: "memory");
        RAW_BARRIER();
        if (j + 1 < nk) GEMM_ISSUE((j + 1) & 1, (j + 1) * 64);
        const unsigned char* As = lds + (j & 1) * 32768; const unsigned char* Bs = As + 16384;
        bf16x8 a[2][2], b[2][2];
#define GEMM_FRAGS(ks, buf)                                                                            \
        do {                                                                                           \
            const int pc = ((2 * (ks) + hh) ^ key) * 16;                                               \
            _Pragma("unroll") for (int mi = 0; mi < 2; ++mi) a[buf][mi] = *(const bf16x8*)(As + (64 * wm + 32 * mi + l32) * 128 + pc); \
            _Pragma("unroll") for (int ni = 0; ni < 2; ++ni) b[buf][ni] = *(const bf16x8*)(Bs + (64 * wn + 32 * ni + l32) * 128 + pc); \
        } while (0)
        GEMM_FRAGS(0, 0);
#pragma unroll
        for (int ks = 0; ks < 4; ++ks) {
            if (ks < 3) GEMM_FRAGS(ks + 1, (ks + 1) & 1);
#pragma unroll
            for (int mi = 0; mi < 2; ++mi)
#pragma unroll
                for (int ni = 0; ni < 2; ++ni) acc[mi][ni] = MFMA32(a[ks & 1][mi], b[ks & 1][ni], acc[mi][ni]);
        }
#undef GEMM_FRAGS
    }
#undef GEMM_ISSUE
    RAW_BARRIER();
}
DI bool xcd_tile(int iter, int MT, int NT, int& mt, int& nt) {
    const int x = blockIdx.x & 7, li = blockIdx.x >> 3, per = gridDim.x >> 3;
    const int base = MT >> 3, rem_tiles = (MT - 8 * base) * NT, extra = (rem_tiles + 7) >> 3;
    const int m_lo = x * base;
    int t = li + per * iter;
    if (t < base * NT) {
        const int nfull = NT >> 3, gsz = base * 8;
        if (t < nfull * gsz) { const int g = t / gsz, r = t - g * gsz; mt = m_lo + (r >> 3); nt = 8 * g + (r & 7); }
        else { const int r = t - nfull * gsz, wdt = NT - 8 * nfull; mt = m_lo + r / wdt; nt = 8 * nfull + r % wdt; }
        return true;
    }
    t -= base * NT;
    if (t >= extra) return false;
    const int e = x * extra + t;
    if (e >= rem_tiles) return false;
    mt = 8 * base + e / NT; nt = e % NT;
    return true;
}
constexpr int ELD = 129;
DI void stage_acc(const f32x16 (&acc)[2][2], unsigned char* lds) {
    const int tid = tidx(), lane = tid & 63, w = tid >> 6, wm = w >> 1, wn = w & 1, l32 = lane & 31, hh = lane >> 5;
    float* E = (float*)lds;
#pragma unroll
    for (int mi = 0; mi < 2; ++mi)
#pragma unroll
        for (int ni = 0; ni < 2; ++ni)
#pragma unroll
            for (int i = 0; i < 16; ++i) {
                const int row = 64 * wm + 32 * mi + 8 * (i >> 2) + 4 * hh + (i & 3), col = 64 * wn + 32 * ni + l32;
                E[row * ELD + col] = acc[mi][ni][i];
            }
    __syncthreads();
}
DI void store_acc_f32(const f32x16 (&acc)[2][2], float* Y, int ldy) {
    const int tid = tidx(), lane = tid & 63, w = tid >> 6, wm = w >> 1, wn = w & 1, l32 = lane & 31, hh = lane >> 5;
#pragma unroll
    for (int mi = 0; mi < 2; ++mi)
#pragma unroll
        for (int ni = 0; ni < 2; ++ni)
#pragma unroll
            for (int i = 0; i < 16; ++i) {
                const int row = 64 * wm + 32 * mi + 8 * (i >> 2) + 4 * hh + (i & 3), col = 64 * wn + 32 * ni + l32;
                Y[(size_t)row * ldy + col] = acc[mi][ni][i];
            }
}

DI void conv_tile(const float* __restrict__ src, int ld, int N, int k0, int n0, bf16* __restrict__ dst, int ldd, int mode, int row_off, unsigned char* lds) {
    float* Tt = (float*)lds;
    const int tid = tidx();
#pragma unroll
    for (int i = 0; i < 4; ++i) {
        const int r = (tid >> 4) + 16 * i, c4 = (tid & 15) * 4;
        f32x4 v = {0.f, 0.f, 0.f, 0.f};
        if (n0 + c4 + 3 < N) v = *(const f32x4*)(src + (size_t)(k0 + r) * ld + n0 + c4);
        Tt[r * 65 + c4 + 0] = v[0]; Tt[r * 65 + c4 + 1] = v[1]; Tt[r * 65 + c4 + 2] = v[2]; Tt[r * 65 + c4 + 3] = v[3];
    }
    __syncthreads();
    {
        const int n = tid >> 2, kq = tid & 3;
        if (n0 + n < N) {
            unsigned pk[8];
#pragma unroll
            for (int e = 0; e < 8; ++e) pk[e] = pack2(Tt[(16 * kq + 2 * e) * 65 + n], Tt[(16 * kq + 2 * e + 1) * 65 + n]);
            int cidx = n0 + n, drow;
            if (mode == 1) { const int f = cidx % DFF, isv = cidx / DFF; drow = (f >> 6) * 128 + isv * 64 + (f & 63); } else drow = cidx + row_off;
            u32x4* d = (u32x4*)(dst + (size_t)drow * ldd + k0 + 16 * kq);
            d[0] = (u32x4){pk[0], pk[1], pk[2], pk[3]}; d[1] = (u32x4){pk[4], pk[5], pk[6], pk[7]};
        }
    }
    __syncthreads();
}
DI int conv_count(int l) { return ((l & 1) ? 768 + 32 : 512) + 256 + 1408 + 704; }
DI void convert_item(const Params& p, int l, int it, unsigned char* lds) {
    const int j = l >> 1; const bool gla = l & 1; bf16* W = (bf16*)(p.ws + OFF_WTS);
    const int n_in = gla ? 768 : 512;
    if (it < n_in) {
        const int NT = gla ? 48 : 32, N = gla ? 3072 : 2048;
        const float* src = gla ? p.g_win + (size_t)j * 1024 * 3072 : p.a_win + (size_t)j * 1024 * 2048;
        conv_tile(src, N, N, (it / NT) * 64, (it % NT) * 64, W + W_IN, 1024, 0, 0, lds); return;
    }
    it -= n_in;
    if (gla) {
        if (it < 32) { const int z = it >> 4, kt = it & 15; conv_tile(p.g_wa1 + (size_t)((j * 2 + z) * 1024) * 16, 16, 16, kt * 64, 0, W + W_IN, 1024, 0, 3072 + z * 16, lds); return; }
        it -= 32;
    }
    if (it < 256) { const float* src = gla ? p.g_wout + (size_t)j * 1024 * 1024 : p.a_wout + (size_t)j * 1024 * 1024; conv_tile(src, 1024, 1024, (it >> 4) * 64, (it & 15) * 64, W + W_OUT, 1024, 0, 0, lds); return; }
    it -= 256;
    if (it < 1408) { conv_tile(p.up_w + (size_t)l * 1024 * 5632, 5632, 5632, (it / 88) * 64, (it % 88) * 64, W + W_UP, 1024, 1, 0, lds); return; }
    it -= 1408;
    conv_tile(p.down_w + (size_t)l * 2816 * 1024, 1024, 1024, (it >> 4) * 64, (it & 15) * 64, W + W_DOWN, 2816, 0, 0, lds);
}

DI void mod_item(const Params& p, int it, unsigned char* lds) {
    const int l = it / 96, j0 = (it % 96) * 64, tid = tidx();
    float* sv = (float*)lds; float* red = (float*)(lds + 12288);
    for (int i = tid; i < 3072; i += 256) { const int v = i >> 10, k = i & 1023; const float cv = v < 2 ? p.c[v * 1024 + k] : p.c_ctx[k]; sv[i] = cv / (1.f + expf(-cv)); }
    __syncthreads();
    const int cl = tid & 63, kg = tid >> 6;
    const float* wp = p.ada_w + (size_t)l * 1024 * 6144 + (size_t)(kg * 256) * 6144 + j0 + cl;
    float a0 = 0.f, a1 = 0.f, a2 = 0.f;
#pragma unroll 32
    for (int k = 0; k < 256; ++k) { const float wv = wp[(size_t)k * 6144]; a0 += sv[kg * 256 + k] * wv; a1 += sv[1024 + kg * 256 + k] * wv; a2 += sv[2048 + kg * 256 + k] * wv; }
    red[(kg * 3 + 0) * 64 + cl] = a0; red[(kg * 3 + 1) * 64 + cl] = a1; red[(kg * 3 + 2) * 64 + cl] = a2;
    __syncthreads();
    if (tid < 192) {
        const int v = tid >> 6; float s = 0.f;
#pragma unroll
        for (int g = 0; g < 4; ++g) s += red[(g * 3 + v) * 64 + cl];
        ((float*)(p.ws + OFF_MOD))[(l * 3 + v) * 6144 + j0 + cl] = s + p.ada_b[l * 6144 + j0 + cl];
    }
    __syncthreads();
}
DI void phase_prep_a(const Params& p, unsigned char* lds) {
    const int n_mod = 384, n_rope = 512, n_conv = conv_count(0), total = n_mod + n_rope + n_conv;
    for (int it = blockIdx.x; it < total; it += gridDim.x) {
        if (it < n_mod) mod_item(p, it, lds);
        else if (it < n_mod + n_rope) {
            float* C = (float*)(p.ws + OFF_COS); float* S = (float*)(p.ws + OFF_SIN);
#pragma unroll
            for (int k = 0; k < 4; ++k) {
                const int e = (it - n_mod) * 1024 + tidx() + 256 * k, pos = e >> 6, i = e & 63, jj = i & 31;
                const float inv = powf(10000.f, -(float)jj * 2.0f / 64.0f);
                const float ang = (float)(i < 32 ? (pos >> 6) : (pos & 63)) * inv;
                C[e] = cosf(ang); S[e] = sinf(ang);
            }
        } else convert_item(p, 0, it - n_mod - n_rope, lds);
    }
}
DI int row_modv(int row) { return row < TL ? (row >> 13) : 2; }
DI void phase_prep_b(const Params& p) {
    const int lane = tidx() & 63, gw = blockIdx.x * 4 + (tidx() >> 6), nw = gridDim.x * 4;
    float* H = (float*)(p.ws + OFF_H); bf16* ABF = (bf16*)(p.ws + OFF_ABF); const float* MOD = (const float*)(p.ws + OFF_MOD);
    for (int row = gw; row < TA; row += nw) {
        const float* src = row < TL ? p.x + (size_t)row * 1024 : p.ctx + (size_t)(row - TL) * 1024;
        const float* md = MOD + (0 * 3 + row_modv(row)) * 6144;
#pragma unroll
        for (int i = 0; i < 4; ++i) {
            const int c = 4 * lane + 256 * i;
            const f32x4 v = *(const f32x4*)(src + c), sh = *(const f32x4*)(md + c), sc = *(const f32x4*)(md + 1024 + c);
            *(f32x4*)(H + (size_t)row * 1024 + c) = v;
            u32x2 o; o.x = pack2(v[0] * (1.f + sc[0]) + sh[0], v[1] * (1.f + sc[1]) + sh[1]); o.y = pack2(v[2] * (1.f + sc[2]) + sh[2], v[3] * (1.f + sc[3]) + sh[3]);
            *(u32x2*)(ABF + (size_t)row * 1024 + c) = o;
        }
    }
}
DI void phase_ln(const Params& p, int l, int which, int nrows) {
    const int lane = tidx() & 63, gw = blockIdx.x * 4 + (tidx() >> 6), nw = gridDim.x * 4;
    float* H = (float*)(p.ws + OFF_H); bf16* ABF = (bf16*)(p.ws + OFF_ABF); const float* MOD = (const float*)(p.ws + OFF_MOD);
    const float* Y = (const float*)(p.ws + S_Y); const float* P = (const float*)(p.ws + S_OB);
    const int KS = which ? 11 : 16;
    const float* lg = p.ln_g + (l * 2 + which) * 1024; const float* lb = p.ln_b + (l * 2 + which) * 1024;
    const bool last = (which == 1 && l == 3);
    for (int row = gw; row < nrows; row += nw) {
        const int mv = row_modv(row);
        const float* gate = MOD + (l * 3 + mv) * 6144 + (which ? 5 : 2) * 1024;
        const float* nsh = which ? MOD + ((l + 1) * 3 + mv) * 6144 : MOD + (l * 3 + mv) * 6144 + 3 * 1024;
        const float* nsc = nsh + 1024;
        f32x4 v[4]; float s = 0.f;
#pragma unroll
        for (int i = 0; i < 4; ++i) {
            const int c = 4 * lane + 256 * i;
            const f32x4 h = *(const f32x4*)(H + (size_t)row * 1024 + c), g = *(const f32x4*)(gate + c);
            f32x4 y;
            if (row < TL) y = *(const f32x4*)(Y + (size_t)row * 1024 + c);
            else { y = (f32x4){0.f, 0.f, 0.f, 0.f}; for (int ks = 0; ks < KS; ++ks) y += *(const f32x4*)(P + ((size_t)ks * 512 + (row - TL)) * 1024 + c); }
            v[i] = ALPHA * h + g * y; s += (v[i][0] + v[i][1]) + (v[i][2] + v[i][3]);
        }
        const float mu = wave_sum(s) * (1.f / 1024.f); float q = 0.f;
#pragma unroll
        for (int i = 0; i < 4; ++i) { const f32x4 d = v[i] - mu; q += (d[0] * d[0] + d[1] * d[1]) + (d[2] * d[2] + d[3] * d[3]); }
        const float rstd = rsqrtf(wave_sum(q) * (1.f / 1024.f) + EPS);
#pragma unroll
        for (int i = 0; i < 4; ++i) {
            const int c = 4 * lane + 256 * i;
            const f32x4 o = (v[i] - mu) * rstd * *(const f32x4*)(lg + c) + *(const f32x4*)(lb + c);
            if (last) { *(f32x4*)(p.out + (size_t)row * 1024 + c) = o; }
            else {
                *(f32x4*)(H + (size_t)row * 1024 + c) = o;
                const f32x4 sh = *(const f32x4*)(nsh + c), sc = *(const f32x4*)(nsc + c);
                u32x2 ob; ob.x = pack2(o[0] * (1.f + sc[0]) + sh[0], o[1] * (1.f + sc[1]) + sh[1]); ob.y = pack2(o[2] * (1.f + sc[2]) + sh[2], o[3] * (1.f + sc[3]) + sh[3]);
                *(u32x2*)(ABF + (size_t)row * 1024 + c) = ob;
            }
        }
    }
}

DI void phase_attn_in(const Params& p, int j, unsigned char* lds) {
    const bf16* ABF = (const bf16*)(p.ws + OFF_ABF); const bf16* W = (const bf16*)(p.ws + OFF_WTS) + W_IN;
    bf16* QK = (bf16*)(p.ws + S_QK); bf16* VT = (bf16*)(p.ws + S_VT);
    const float* COS = (const float*)(p.ws + OFF_COS); const float* SIN = (const float*)(p.ws + OFF_SIN);
    const int lane = tidx() & 63, w = tidx() >> 6;
    const bf16* ZB = (const bf16*)(p.ws + OFF_ZERO);
    for (int iter = 0;; ++iter) {
        int mt, nt; if (!xcd_tile(iter, 132, 16, mt, nt)) break;
        const int m0 = mt * 128;
        f32x16 acc[2][2];
        gemm_tile(ARowPlain{ABF + (size_t)m0 * 1024, 1024}, W + (size_t)nt * 128 * 1024, 1024, 1024, acc, lds, ZB);
        stage_acc(acc, lds);
        const float* E = (const float*)lds;
        const bool lat = mt < 128;
        const int b = lat ? (mt >> 6) : ((mt - 128) >> 1);
        const int pos0 = lat ? (mt & 63) * 128 : ((mt - 128) & 1) * 128;
        const bool isv = (nt == 6 || nt == 7 || nt >= 14);
        if (isv) {
            const int vh = nt < 8 ? nt - 6 : 2 + nt - 14;
            bf16* vb = VT + (size_t)((b * 4 + vh) * 128) * VTLD + (lat ? pos0 : 8192 + pos0);
#pragma unroll
            for (int half = 0; half < 2; ++half) {
                const int tok = 64 * half + lane;
                for (int d = w; d < 128; d += 4) vb[(size_t)d * VTLD + tok] = f2bf(E[tok * ELD + d]);
            }
        } else {
            const bool norm = nt < 6;
            const int colbase = nt < 4 ? nt * 128 : (nt < 6 ? 512 + (nt - 4) * 128 : (nt < 12 ? 768 + (nt - 8) * 128 : 1280 + (nt - 12) * 128));
            const float* gw = nt < 4 ? p.a_qn + j * 128 : p.a_kn + j * 128;
            const float g1 = norm ? gw[lane] : 1.f, g2 = norm ? gw[64 + lane] : 1.f;
            for (int rr = 0; rr < 32; ++rr) {
                const int r = 32 * w + rr;
                float x1 = E[r * ELD + lane], x2 = E[r * ELD + 64 + lane];
                if (norm) { const float ss = wave_sum(x1 * x1 + x2 * x2); const float rs = rsqrtf(ss * (1.f / 128.f) + EPS); x1 = x1 * rs * g1; x2 = x2 * rs * g2; }
                float o1 = x1, o2 = x2;
                if (lat) { const int pos = pos0 + r; const float cs = COS[pos * 64 + lane], sn = SIN[pos * 64 + lane]; o1 = x1 * cs - x2 * sn; o2 = x1 * sn + x2 * cs; }
                bf16* dst = QK + (size_t)(m0 + r) * 1536 + colbase;
                dst[lane] = f2bf(o1); dst[64 + lane] = f2bf(o2);
            }
        }
        __syncthreads();
    }
}

DI void attn_item(const Params& p, int j, int it, unsigned char* lds) {
    const int tid = tidx(), lane = tid & 63, w = tid >> 6, l32 = lane & 31, hh = lane >> 5;
    int type;
    if (it < 512) type = 0; else if (it < 1024) { type = 1; it -= 512; } else if (it < 1040) { type = 2; it -= 1024; } else { type = 3; it -= 1040; }
    int b, qh, qb;
    if (type < 2) { qb = it & 63; qh = (it >> 6) & 3; b = it >> 8; } else { qb = it & 1; qh = (it >> 1) & 3; b = it >> 3; }
    const bool win = type & 1, isctx = type >= 2;
    const int qrow0 = isctx ? TL + b * 256 + qb * 128 : b * 8192 + qb * 128;
    const int qcol = win ? 768 + qh * 128 : qh * 128;
    const int kcol = win ? 1280 + (qh >> 1) * 128 : 512 + (qh >> 1) * 128;
    const int vhead = b * 4 + (win ? 2 : 0) + (qh >> 1);
    const int ocol = (win ? 512 : 0) + qh * 128;
    const int nbk = 1 + (qb > 0 ? 1 : 0) + (qb < 63 ? 1 : 0);
    const int nlat = isctx ? 0 : (win ? 2 * nbk : 128);
    const int ntiles = nlat + 4;
    const bf16* QK = (const bf16*)(p.ws + S_QK); const bf16* VT = (const bf16*)(p.ws + S_VT) + (size_t)vhead * 128 * VTLD;
    bf16* MIX = (bf16*)(p.ws + S_MIX);
    bf16x8 qf[8];
    {
        const bf16* qp = QK + (size_t)(qrow0 + 32 * w + l32) * 1536 + qcol + 8 * hh;
#pragma unroll
        for (int ks = 0; ks < 8; ++ks) qf[ks] = *(const bf16x8*)(qp + 16 * ks);
    }
    f32x16 O[4];
#pragma unroll
    for (int mt = 0; mt < 4; ++mt)
#pragma unroll
        for (int i = 0; i < 16; ++i) O[mt][i] = 0.f;
    float m_run = -INFINITY, l_run = 0.f;
    const float cscale = 0.08838834764831845f * 1.4426950408889634f;
    const int qpos = qb * 128 + 32 * w + l32;
    int krow0, vcol0, kpos0; bool msk;
    const int k_r = lane >> 4, k_pc = lane & 15;
    const int v_r = lane >> 3, v_pc = lane & 7;
    const int kperm = (l32 & 0x13) | ((l32 & 4) << 1) | ((l32 & 8) >> 1);
#define TILE_INFO(tj)                                                                                         \
    do {                                                                                                      \
        if ((tj) < nlat) {                                                                                    \
            int kp;                                                                                           \
            if (!win) kp = (tj) * 64;                                                                         \
            else { const int bi = (tj) >> 1; const int blk = bi == 0 ? qb : (bi == 1 ? (qb > 0 ? qb - 1 : qb + 1) : qb + 1); kp = blk * 128 + ((tj) & 1) * 64; } \
            krow0 = b * 8192 + kp; vcol0 = kp; kpos0 = kp; msk = win;                                         \
        } else { const int cc = (tj) - nlat; krow0 = TL + b * 256 + cc * 64; vcol0 = 8192 + cc * 64; kpos0 = 0; msk = false; } \
    } while (0)
#define ISSUE_LOADS(stage)                                                                                    \
    do {                                                                                                      \
        _Pragma("unroll") for (int i = 0; i < 4; ++i) {                                                       \
            const int kr = 16 * w + 4 * i + k_r, vr = 32 * w + 8 * i + v_r;                                   \
            __builtin_amdgcn_global_load_lds((const unsigned*)(QK + (size_t)(krow0 + kr) * 1536 + kcol + ((k_pc ^ (kr & 15)) * 8)), (LAS unsigned*)(lds + (stage) * 32768 + w * 4096 + i * 1024), 16, 0, 0); \
            __builtin_amdgcn_global_load_lds((const unsigned*)(VT + (size_t)vr * VTLD + vcol0 + ((v_pc ^ ((vr >> 1) & 7)) * 8)), (LAS unsigned*)(lds + (stage) * 32768 + 16384 + w * 4096 + i * 1024), 16, 0, 0); \
        }                                                                                                     \
    } while (0)
    int koff[8], voff[4];
#pragma unroll
    for (int ks = 0; ks < 8; ++ks) koff[ks] = kperm * 256 + (((2 * ks + hh) ^ (kperm & 15)) * 16);
#pragma unroll
    for (int kk = 0; kk < 4; ++kk) voff[kk] = 16384 + l32 * 128 + (((2 * kk + hh) ^ ((l32 >> 1) & 7)) * 16);
    TILE_INFO(0);
    ISSUE_LOADS(0);
    for (int tj = 0; tj < ntiles; ++tj) {
        const int c_kpos0 = kpos0; const bool c_msk = msk;
        asm volatile("s_waitcnt vmcnt(0)" ::: "memory");
        RAW_BARRIER();
        if (tj + 1 < ntiles) { TILE_INFO(tj + 1); ISSUE_LOADS((tj + 1) & 1); }
        const unsigned char* Kst = lds + (tj & 1) * 32768;
        f32x16 S[2];
#pragma unroll
        for (int st = 0; st < 2; ++st)
#pragma unroll
            for (int i = 0; i < 16; ++i) S[st][i] = 0.f;
#pragma unroll
        for (int ks = 0; ks < 8; ++ks)
#pragma unroll
            for (int st = 0; st < 2; ++st) {
                const bf16x8 ak = *(const bf16x8*)(Kst + koff[ks] + st * 8192);
                S[st] = MFMA32(ak, qf[ks], S[st]);
            }
        float mx = -INFINITY;
        if (c_msk) {
#pragma unroll
            for (int st = 0; st < 2; ++st)
#pragma unroll
                for (int i = 0; i < 16; ++i) {
                    const int kp = c_kpos0 + 32 * st + 16 * (i >> 3) + 8 * hh + 4 * ((i >> 2) & 1) + (i & 3); const int df = kp - qpos;
                    if (df > 128 || df < -128) S[st][i] = -INFINITY;
                }
        }
#pragma unroll
        for (int st = 0; st < 2; ++st)
#pragma unroll
            for (int i = 0; i < 16; ++i) mx = fmaxf(mx, S[st][i]);
        mx = fmaxf(mx, __shfl_xor(mx, 32));
        if (__any((mx - m_run) * cscale > 8.f)) {
            const float m_new = fmaxf(m_run, mx);
            const float alpha = __builtin_amdgcn_exp2f((m_run - m_new) * cscale);
            m_run = m_new; l_run *= alpha;
#pragma unroll
            for (int mt = 0; mt < 4; ++mt) O[mt] = O[mt] * alpha;
        }
        const float mref = -m_run * cscale;
        float ps = 0.f;
#pragma unroll
        for (int st = 0; st < 2; ++st)
#pragma unroll
            for (int i = 0; i < 16; ++i) { const float pv = __builtin_amdgcn_exp2f(__builtin_fmaf(S[st][i], cscale, mref)); S[st][i] = pv; ps += pv; }
        l_run += ps;
        bf16x8 P[4];
#pragma unroll
        for (int kk = 0; kk < 4; ++kk) { const int st = kk >> 1, o = (kk & 1) * 8; P[kk] = pack8(S[st][o], S[st][o + 1], S[st][o + 2], S[st][o + 3], S[st][o + 4], S[st][o + 5], S[st][o + 6], S[st][o + 7]); }
#pragma unroll
        for (int mt = 0; mt < 4; ++mt)
#pragma unroll
            for (int kk = 0; kk < 4; ++kk) {
                const bf16x8 av = *(const bf16x8*)(Kst + voff[kk] + mt * 4096);
                O[mt] = MFMA32(av, P[kk], O[mt]);
            }
    }
#undef TILE_INFO
#undef ISSUE_LOADS
    RAW_BARRIER();
    float l_tot = l_run + __shfl_xor(l_run, 32);
    if (win) l_tot += __builtin_amdgcn_exp2f(p.a_sink[j * 4 + qh] * 1.4426950408889634f - m_run * cscale);
    const float inv = 1.f / l_tot;
    __syncthreads();
    bf16* Os = (bf16*)lds;
#pragma unroll
    for (int mt = 0; mt < 4; ++mt)
#pragma unroll
        for (int i = 0; i < 16; ++i) Os[(32 * w + l32) * 136 + 32 * mt + 8 * (i >> 2) + 4 * hh + (i & 3)] = f2bf(O[mt][i] * inv);
    __syncthreads();
#pragma unroll
    for (int i = 0; i < 8; ++i) {
        const int row = (tid >> 4) + 16 * i, ch = tid & 15;
        *(u32x4*)(MIX + (size_t)(qrow0 + row) * 1024 + ocol + ch * 8) = *(const u32x4*)(Os + row * 136 + ch * 8);
    }
    __syncthreads();
}

DI void phase_gemm_y(const Params& p, const bf16* A, int lda, const bf16* Bt, int K, bool need_ctx, unsigned char* lds) {
    float* Y = (float*)(p.ws + S_Y); float* P = (float*)(p.ws + S_OB);
    const bf16* ZB = (const bf16*)(p.ws + OFF_ZERO);
    if (need_ctx) {
        const int KS = (K == 1024) ? 16 : 11, klen = K / KS, items = 32 * KS;
        for (int it = blockIdx.x; it < items; it += gridDim.x) {
            const int ct = it / KS, ks = it - ct * KS, cm = ct >> 3, nt = ct & 7;
            f32x16 acc[2][2];
            gemm_tile(ARowPlain{A + (size_t)(TL + cm * 128) * lda + ks * klen, lda}, Bt + (size_t)nt * 128 * K + ks * klen, K, klen, acc, lds, ZB);
            store_acc_f32(acc, P + ((size_t)ks * 512 + cm * 128) * 1024 + nt * 128, 1024);
        }
    }
    for (int iter = 0;; ++iter) {
        int mt, nt; if (!xcd_tile(iter, 128, 8, mt, nt)) break;
        f32x16 acc[2][2];
        gemm_tile(ARowPlain{A + (size_t)mt * 128 * lda, lda}, Bt + (size_t)nt * 128 * K, K, K, acc, lds, ZB);
        store_acc_f32(acc, Y + (size_t)mt * 128 * 1024 + nt * 128, 1024);
    }
}
DI void phase_up(const Params& p, int l, bool need_ctx, unsigned char* lds) {
    const bf16* ABF = (const bf16*)(p.ws + OFF_ABF); const bf16* W = (const bf16*)(p.ws + OFF_WTS) + W_UP;
    bf16* A2 = (bf16*)(p.ws + S_A2);
    const int lane = tidx() & 63, w = tidx() >> 6;
    const int mtiles = need_ctx ? 138 : 132;
    const bf16* ZB = (const bf16*)(p.ws + OFF_ZERO);
    const float* cw = p.conv_w + (size_t)l * 3 * 5632; const float* cb = p.conv_b + (size_t)l * 5632;
    for (int iter = 0;; ++iter) {
        int mi, nt; if (!xcd_tile(iter, mtiles, 44, mi, nt)) break;
        int seqbase, len, ti;
        if (mi < 132) { seqbase = (mi / 66) * 8192; len = 8192; ti = mi % 66; } else { const int cc = mi - 132; seqbase = TL + (cc / 3) * 256; len = 256; ti = cc % 3; }
        f32x16 acc[2][2];
        gemm_tile(ARowHalo{ABF + (size_t)seqbase * 1024, 1024, 126 * ti - 1, len}, W + (size_t)nt * 128 * 1024, 1024, 1024, acc, lds, ZB);
        stage_acc(acc, lds);
        const float* E = (const float*)lds;
        const int fg = nt * 64 + lane;
        const float g0 = cw[fg], g1 = cw[5632 + fg], g2 = cw[2 * 5632 + fg], gb = cb[fg];
        const float v0 = cw[DFF + fg], v1 = cw[5632 + DFF + fg], v2 = cw[2 * 5632 + DFF + fg], vb = cb[DFF + fg];
        for (int r = 1 + w; r <= 126; r += 4) {
            const int pos = 126 * ti - 1 + r;
            if (pos < len) {
                const float G = gb + g0 * E[(r - 1) * ELD + lane] + g1 * E[r * ELD + lane] + g2 * E[(r + 1) * ELD + lane];
                const float V = vb + v0 * E[(r - 1) * ELD + 64 + lane] + v1 * E[r * ELD + 64 + lane] + v2 * E[(r + 1) * ELD + 64 + lane];
                A2[(size_t)(seqbase + pos) * DFF + fg] = f2bf(silu(G) * V);
            }
        }
        __syncthreads();
    }
}

DI void phase_gla_in(const Params& p, unsigned char* lds) {
    const bf16* ABF = (const bf16*)(p.ws + OFF_ABF); const bf16* W = (const bf16*)(p.ws + OFF_WTS) + W_IN;
    bf16* QKR = (bf16*)(p.ws + S_QKR); bf16* VTG = (bf16*)(p.ws + S_VTG); bf16* G = (bf16*)(p.ws + S_MIX); float* LOW = (float*)(p.ws + S_LOW);
    const int lane = tidx() & 63, w = tidx() >> 6;
    const bf16* ZB = (const bf16*)(p.ws + OFF_ZERO);
    for (int iter = 0;; ++iter) {
        int mt, nt; if (!xcd_tile(iter, 132, 25, mt, nt)) break;
        const int m0 = mt * 128;
        f32x16 acc[2][2];
        gemm_tile(ARowPlain{ABF + (size_t)m0 * 1024, 1024}, W + (size_t)nt * 128 * 1024, 1024, 1024, acc, lds, ZB);
        stage_acc(acc, lds);
        const float* E = (const float*)lds;
        const bool lat = mt < 128;
        const int b = lat ? (mt >> 6) : ((mt - 128) >> 1);
        const int pos0 = lat ? (mt & 63) * 128 : 8192 + ((mt - 128) & 1) * 128;
        if (nt >= 8 && nt < 16) {
            bf16* vb = VTG + (size_t)(b * 1024 + (nt - 8) * 128) * VTLD + pos0;
#pragma unroll
            for (int half = 0; half < 2; ++half) {
                const int tok = 64 * half + lane;
                for (int d = w; d < 128; d += 4) vb[(size_t)d * VTLD + tok] = f2bf(E[tok * ELD + d]);
            }
        } else if (nt == 24) {
            for (int rr = 0; rr < 32; ++rr) { const int r = 32 * w + rr; if (lane < 32) LOW[(size_t)(m0 + r) * 32 + lane] = E[r * ELD + lane]; }
        } else {
            bf16* dst0 = nt < 8 ? QKR + nt * 128 : G + (nt - 16) * 128;
            for (int rr = 0; rr < 32; ++rr) {
                const int r = 32 * w + rr;
                bf16* dst = dst0 + (size_t)(m0 + r) * 1024;
                dst[lane] = f2bf(E[r * ELD + lane]); dst[64 + lane] = f2bf(E[r * ELD + 64 + lane]);
            }
        }
        __syncthreads();
    }
}
DI float logsig(float x) { return fminf(x, 0.f) - __logf(1.f + __expf(-fabsf(x))); }

DI void gla_intra_item(const Params& p, int j, int it, unsigned char* lds) {
    const int tid = tidx(), lane = tid & 63, w = tid >> 6, l32 = lane & 31, hh = lane >> 5;
    const int h = it & 3, cidx = it >> 2;
    const int row0 = cidx * 64;
    int b, tokpos0;
    if (cidx < 256) { b = cidx >> 7; tokpos0 = (cidx & 127) * 64; } else { b = (cidx - 256) >> 2; tokpos0 = 8192 + ((cidx - 256) & 3) * 64; }
    float* Ls = (float*)lds;
    bf16* Vs = (bf16*)(lds + 8192);
    bf16* Qs = (bf16*)(lds + 8192 + 18432);
    bf16* Ks = Qs + 64 * 136;
    float* HS = (float*)(lds + 8192 + 18432 + 2 * 17408);
    const bf16* QKR = (const bf16*)(p.ws + S_QKR); const bf16* VTG = (const bf16*)(p.ws + S_VTG); const float* LOW = (const float*)(p.ws + S_LOW);
    bf16* QH = (bf16*)(p.ws + S_QH); bf16* KT = (bf16*)(p.ws + OFF_ABF); float* EXPL = (float*)(p.ws + S_EXPL); bf16* OI = (bf16*)(p.ws + S_OI);
    u32x4 rq[4], rk[4];
    {
        const f32x4* src = (const f32x4*)(LOW + (size_t)row0 * 32);
        ((f32x4*)Ls)[tid] = src[tid]; ((f32x4*)Ls)[tid + 256] = src[tid + 256];
#pragma unroll
        for (int i = 0; i < 4; ++i) {
            const bf16* qp = QKR + (size_t)(row0 + (tid >> 4) + 16 * i) * 1024 + h * 128 + (tid & 15) * 8;
            rq[i] = *(const u32x4*)qp; rk[i] = *(const u32x4*)(qp + 512);
        }
#pragma unroll
        for (int i = 0; i < 4; ++i) {
            *(u32x4*)(Qs + ((tid >> 4) + 16 * i) * 136 + (tid & 15) * 8) = rq[i];
            *(u32x4*)(Ks + ((tid >> 4) + 16 * i) * 136 + (tid & 15) * 8) = rk[i];
        }
    }
    __syncthreads();
    const int d = tid & 127, rh = tid >> 7;
    const int tt = w & 1, nq = w >> 1;
    bf16x8 P[2][4];
#pragma unroll
    for (int dir = 0; dir < 2; ++dir) {
        float w2[16];
#pragma unroll
        for (int r = 0; r < 16; ++r) w2[r] = p.g_wa2[(size_t)((j * 2 + dir) * 16 + r) * 512 + h * 128 + d];
        const float bias = p.g_ba[(j * 2 + dir) * 512 + h * 128 + d];
        float ld[32]; float hs = 0.f;
#pragma unroll
        for (int i = 0; i < 32; ++i) {
            const float* lr = Ls + (32 * rh + i) * 32 + dir * 16;
            float x = bias;
#pragma unroll
            for (int r = 0; r < 16; ++r) x += lr[r] * w2[r];
            const float v = logsig(x) * 0.0625f; ld[i] = v; hs += v;
        }
        HS[rh * 128 + d] = hs;
        __syncthreads();
        const float other = HS[(1 - rh) * 128 + d];
        float run = (dir == 0) ? (rh ? other : 0.f) : (rh ? 0.f : other);
#pragma unroll
        for (int ii = 0; ii < 32; ++ii) {
            const int i = dir == 0 ? ii : 31 - ii;
            const int r = 32 * rh + i;
            run += ld[i];
            const float eq = __expf(run);
            const bf16 qv = f2bf(bf2f(Qs[r * 136 + d]) * eq * 0.08838834764831845f), kv = f2bf(bf2f(Ks[r * 136 + d]) * __builtin_amdgcn_rcpf(eq));
            Qs[r * 136 + d] = qv; Ks[r * 136 + d] = kv;
            QH[((size_t)dir * TA + row0 + r) * 512 + h * 128 + d] = qv;
        }
        if (rh == 0) EXPL[(size_t)(dir * 264 + cidx) * 512 + h * 128 + d] = __expf(hs + other);
        __syncthreads();
        {
            const int dd = tid >> 1, sh = tid & 1; unsigned pk[16];
#pragma unroll
            for (int e = 0; e < 16; ++e) pk[e] = (unsigned)Ks[(32 * sh + 2 * e) * 136 + dd] | ((unsigned)Ks[(32 * sh + 2 * e + 1) * 136 + dd] << 16);
            u32x4* dst = (u32x4*)(KT + ((size_t)(dir * 264 + cidx) * 512 + h * 128 + dd) * 64 + 32 * sh);
            dst[0] = (u32x4){pk[0], pk[1], pk[2], pk[3]}; dst[1] = (u32x4){pk[4], pk[5], pk[6], pk[7]};
            dst[2] = (u32x4){pk[8], pk[9], pk[10], pk[11]}; dst[3] = (u32x4){pk[12], pk[13], pk[14], pk[15]};
        }
        f32x16 AT[2];
#pragma unroll
        for (int st = 0; st < 2; ++st)
#pragma unroll
            for (int i = 0; i < 16; ++i) AT[st][i] = 0.f;
#pragma unroll
        for (int ks = 0; ks < 8; ++ks) {
            const bf16x8 bq = *(const bf16x8*)(Qs + (32 * tt + l32) * 136 + 16 * ks + 8 * hh);
#pragma unroll
            for (int st = 0; st < 2; ++st) { const bf16x8 ak = *(const bf16x8*)(Ks + (32 * st + l32) * 136 + 16 * ks + 8 * hh); AT[st] = MFMA32(ak, bq, AT[st]); }
        }
        const int t = 32 * tt + l32;
#pragma unroll
        for (int kk = 0; kk < 4; ++kk) {
            const int st = kk >> 1; float v[8];
#pragma unroll
            for (int e = 0; e < 8; ++e) {
                const int i = (kk & 1) * 8 + e; const int sidx = 32 * st + 8 * (i >> 2) + 4 * hh + (i & 3);
                const bool keep = dir == 0 ? (sidx <= t) : (sidx >= t);
                v[e] = keep ? AT[st][i] : 0.f;
            }
            P[dir][kk] = pack8(v[0], v[1], v[2], v[3], v[4], v[5], v[6], v[7]);
        }
        __syncthreads();
        if (dir == 0) {
#pragma unroll
            for (int i = 0; i < 4; ++i) {
                *(u32x4*)(Qs + ((tid >> 4) + 16 * i) * 136 + (tid & 15) * 8) = rq[i];
                *(u32x4*)(Ks + ((tid >> 4) + 16 * i) * 136 + (tid & 15) * 8) = rk[i];
            }
            __syncthreads();
        }
    }
    bf16* OT = Qs;
#pragma unroll 1
    for (int nh = 0; nh < 2; ++nh) {
#pragma unroll
        for (int i = 0; i < 4; ++i) {
            const int n = (tid >> 3) + 32 * i, ch = tid & 7;
            *(u32x4*)(Vs + n * 72 + ch * 8) = *(const u32x4*)(VTG + (size_t)(b * 1024 + h * 256 + nh * 128 + n) * VTLD + tokpos0 + ch * 8);
        }
        __syncthreads();
        f32x16 O[2];
#pragma unroll
        for (int mt = 0; mt < 2; ++mt)
#pragma unroll
            for (int i = 0; i < 16; ++i) O[mt][i] = 0.f;
#pragma unroll
        for (int mt = 0; mt < 2; ++mt)
#pragma unroll
            for (int kk = 0; kk < 4; ++kk) {
                const bf16* vp = Vs + (64 * nq + 32 * mt + l32) * 72 + 16 * kk + 4 * hh;
                const bf16x8 av = join4(*(const s16x4*)vp, *(const s16x4*)(vp + 8));
                O[mt] = MFMA32(av, P[0][kk], O[mt]); O[mt] = MFMA32(av, P[1][kk], O[mt]);
            }
#pragma unroll
        for (int mt = 0; mt < 2; ++mt)
#pragma unroll
            for (int i = 0; i < 16; ++i) OT[(32 * tt + l32) * 136 + 64 * nq + 32 * mt + 8 * (i >> 2) + 4 * hh + (i & 3)] = f2bf(O[mt][i]);
        __syncthreads();
#pragma unroll
        for (int i = 0; i < 4; ++i) {
            const int row = (tid >> 4) + 16 * i, ch = tid & 15;
            *(u32x4*)(OI + (size_t)(row0 + row) * 1024 + h * 256 + nh * 128 + ch * 8) = *(const u32x4*)(OT + row * 136 + ch * 8);
        }
        __syncthreads();
    }
}

constexpr int NSEG = 8, SEGLEN = 17;
DI void gla_scan_item(const Params& p, int it, int mode, bool write_ctx, unsigned char* lds) {
    const int tid = tidx(), lane = tid & 63, w = tid >> 6, l16 = lane & 15, g = lane >> 4;
    const int seg = it & 7, cs = it >> 3, slice = cs & 3, chain = cs >> 2, dir = chain & 1, h = (chain >> 1) & 3, b = chain >> 3;
    if (mode == 0 && seg == NSEG - 1) return;
    const int s0 = seg * SEGLEN, s1 = (s0 + SEGLEN < 132) ? s0 + SEGLEN : 132;
    bf16* Qs = (bf16*)lds;
    bf16* KTs = (bf16*)(lds + 17408);
    bf16* Vs = (bf16*)(lds + 17408 + 18432);
    float* Es = (float*)(lds + 17408 + 18432 + 9216);
    const bf16* QH = (const bf16*)(p.ws + S_QH); const bf16* KT = (const bf16*)(p.ws + OFF_ABF); const bf16* VTG = (const bf16*)(p.ws + S_VTG);
    const float* EXPL = (const float*)(p.ws + S_EXPL);
    float* SLOC = (float*)(p.ws + S_SLOC); float* DSEG = (float*)(p.ws + S_DSEG);
    bf16* OUT = (bf16*)(p.ws + (dir ? S_OB : S_QKR));
    f32x4 S[8];
#pragma unroll
    for (int mt = 0; mt < 8; ++mt) S[mt] = (f32x4){0.f, 0.f, 0.f, 0.f};
    if (mode) {
        for (int sp = 0; sp < seg; ++sp) {
#pragma unroll
            for (int mt = 0; mt < 8; ++mt) {
                const f32x4 dd = *(const f32x4*)(DSEG + (size_t)(cs * NSEG + sp) * 128 + 16 * mt + 4 * g);
                const f32x4 sl = *(const f32x4*)(SLOC + ((((size_t)(cs * NSEG + sp) * 4 + w) * 8 + mt) * 64 + lane) * 4);
                S[mt] = S[mt] * dd + sl;
            }
        }
    }
    float dprod = 1.f;
    u32x4 rq[4], rk[4], rv[2]; float re = 0.f;
    int cidx, tokpos0;
#define CHUNK_OF(step)                                                                           \
    do {                                                                                         \
        if ((step) < 4) { const int c = dir ? 3 - (step) : (step); cidx = 256 + b * 4 + c; tokpos0 = 8192 + c * 64; } \
        else { int c = (step) - 4; c = dir ? 127 - c : c; cidx = b * 128 + c; tokpos0 = c * 64; } \
    } while (0)
#define SCAN_ISSUE()                                                                             \
    do {                                                                                         \
        _Pragma("unroll") for (int i = 0; i < 4; ++i) {                                          \
            if (mode) rq[i] = *(const u32x4*)(QH + ((size_t)dir * TA + cidx * 64 + (tid >> 4) + 16 * i) * 512 + h * 128 + (tid & 15) * 8); \
            rk[i] = *(const u32x4*)(KT + ((size_t)(dir * 264 + cidx) * 512 + h * 128 + (tid >> 3) + 32 * i) * 64 + (tid & 7) * 8); \
        }                                                                                        \
        _Pragma("unroll") for (int i = 0; i < 2; ++i)                                            \
            rv[i] = *(const u32x4*)(VTG + (size_t)(b * 1024 + h * 256 + slice * 64 + (tid >> 3) + 32 * i) * VTLD + tokpos0 + (tid & 7) * 8); \
        if (tid < 128) re = EXPL[(size_t)(dir * 264 + cidx) * 512 + h * 128 + tid];              \
    } while (0)
#pragma unroll
    for (int i = 0; i < 4; ++i) rq[i] = (u32x4){0u, 0u, 0u, 0u};
    CHUNK_OF(s0);
    SCAN_ISSUE();
    for (int step = s0; step < s1; ++step) {
        const int row0 = cidx * 64;
        __syncthreads();
#pragma unroll
        for (int i = 0; i < 4; ++i) {
            if (mode) *(u32x4*)(Qs + ((tid >> 4) + 16 * i) * 136 + (tid & 15) * 8) = rq[i];
            *(u32x4*)(KTs + ((tid >> 3) + 32 * i) * 72 + (tid & 7) * 8) = rk[i];
        }
#pragma unroll
        for (int i = 0; i < 2; ++i) *(u32x4*)(Vs + ((tid >> 3) + 32 * i) * 72 + (tid & 7) * 8) = rv[i];
        if (tid < 128) { Es[tid] = re; dprod *= re; }
        __syncthreads();
        if (step + 1 < s1) { CHUNK_OF(step + 1); SCAN_ISSUE(); }
        if (mode && (step >= 4 || write_ctx)) {
            bf16x8 bs[4];
#pragma unroll
            for (int jj = 0; jj < 4; ++jj) bs[jj] = pack8(S[2 * jj][0], S[2 * jj][1], S[2 * jj][2], S[2 * jj][3], S[2 * jj + 1][0], S[2 * jj + 1][1], S[2 * jj + 1][2], S[2 * jj + 1][3]);
#pragma unroll
            for (int mtt = 0; mtt < 4; ++mtt) {
                f32x4 o = {0.f, 0.f, 0.f, 0.f};
#pragma unroll
                for (int jj = 0; jj < 4; ++jj) {
                    const bf16* qp = Qs + (16 * mtt + l16) * 136 + 32 * jj + 4 * g;
                    o = MFMA16(join4(*(const s16x4*)qp, *(const s16x4*)(qp + 16)), bs[jj], o);
                }
#pragma unroll
                for (int i = 0; i < 4; ++i) OUT[(size_t)(row0 + 16 * mtt + 4 * g + i) * 1024 + h * 256 + slice * 64 + 16 * w + l16] = f2bf(o[i]);
            }
        }
#pragma unroll
        for (int ks = 0; ks < 2; ++ks) {
            const bf16x8 bv = *(const bf16x8*)(Vs + (16 * w + l16) * 72 + 32 * ks + 8 * g);
#pragma unroll
            for (int mt = 0; mt < 8; ++mt) { const bf16x8 ak = *(const bf16x8*)(KTs + (16 * mt + l16) * 72 + 32 * ks + 8 * g); S[mt] = MFMA16(ak, bv, S[mt]); }
        }
#pragma unroll
        for (int mt = 0; mt < 8; ++mt) { const f32x4 e = *(const f32x4*)(Es + 16 * mt + 4 * g); S[mt] = S[mt] * e; }
    }
#undef CHUNK_OF
#undef SCAN_ISSUE
    if (mode == 0) {
#pragma unroll
        for (int mt = 0; mt < 8; ++mt) *(f32x4*)(SLOC + ((((size_t)(cs * NSEG + seg) * 4 + w) * 8 + mt) * 64 + lane) * 4) = S[mt];
        if (tid < 128) DSEG[(size_t)(cs * NSEG + seg) * 128 + tid] = dprod;
    }
    __syncthreads();
}
DI void phase_gla_comb(const Params& p, int j, int nrows) {
    const int lane = tidx() & 63, gw = blockIdx.x * 4 + (tidx() >> 6), nw = gridDim.x * 4;
    const bf16* OI = (const bf16*)(p.ws + S_OI); const bf16* OF = (const bf16*)(p.ws + S_QKR); const bf16* OB = (const bf16*)(p.ws + S_OB);
    bf16* G = (bf16*)(p.ws + S_MIX);
    const float* hn = p.g_hn + j * 256 + (lane & 15) * 16;
    for (int row = gw; row < nrows; row += nw) {
        const size_t off = (size_t)row * 1024 + lane * 16;
        float o[16]; float ss = 0.f;
#pragma unroll
        for (int q = 0; q < 2; ++q) {
            const u32x4 a = *(const u32x4*)(OI + off + 8 * q), bb = *(const u32x4*)(OF + off + 8 * q), cc = *(const u32x4*)(OB + off + 8 * q);
#pragma unroll
            for (int e = 0; e < 4; ++e) {
                const float lo = bf2f((bf16)(a[e] & 0xffff)) + bf2f((bf16)(bb[e] & 0xffff)) + bf2f((bf16)(cc[e] & 0xffff));
                const float hi = bf2f((bf16)(a[e] >> 16)) + bf2f((bf16)(bb[e] >> 16)) + bf2f((bf16)(cc[e] >> 16));
                o[8 * q + 2 * e] = lo; o[8 * q + 2 * e + 1] = hi; ss += lo * lo + hi * hi;
            }
        }
        ss += __shfl_xor(ss, 1); ss += __shfl_xor(ss, 2); ss += __shfl_xor(ss, 4); ss += __shfl_xor(ss, 8);
        const float rs = rsqrtf(ss * (1.f / 256.f) + EPS);
#pragma unroll
        for (int q = 0; q < 2; ++q) {
            const u32x4 gg = *(const u32x4*)(G + off + 8 * q); u32x4 r;
#pragma unroll
            for (int e = 0; e < 4; ++e) {
                const float g0 = bf2f((bf16)(gg[e] & 0xffff)), g1 = bf2f((bf16)(gg[e] >> 16));
                r[e] = pack2(o[8 * q + 2 * e] * rs * hn[8 * q + 2 * e] * silu(g0), o[8 * q + 2 * e + 1] * rs * hn[8 * q + 2 * e + 1] * silu(g1));
            }
            *(u32x4*)(G + off + 8 * q) = r;
        }
    }
}

enum { K_PREP_A = 0, K_PREP_B, K_A_IN, K_A_ATT, K_OUT, K_LN1, K_UP, K_DOWN, K_LN2, K_G_IN, K_G_INTRA, K_G_SCAN, K_G_COMB, K_G_SCAN2 };
constexpr int NPHASES = 36;
DI void phase_decode(int ph, int& kind, int& layer) {
    if (ph < 2) { kind = ph; layer = 0; return; }
    ph -= 2; const int pair = ph / 17, r = ph - pair * 17;
    if (r < 7) { layer = 2 * pair; kind = r < 2 ? K_A_IN + r : K_OUT + (r - 2); }
    else {
        layer = 2 * pair + 1; const int q = r - 7;
        kind = q == 0 ? K_G_IN : q == 1 ? K_G_INTRA : q == 2 ? K_G_SCAN : q == 3 ? K_G_SCAN2 : q == 4 ? K_G_COMB : K_OUT + (q - 5);
    }
}
DI void run_phase(const Params& pin, int ph, unsigned char* lds) {
    Params p = pin;
    asm volatile("" : "+s"(p.ws));
    int kind, l; phase_decode(ph, kind, l);
    const int j = l >> 1; const bool need_ctx = l < 3; const int nrows = need_ctx ? TA : TL;
#ifdef ONLY_KIND
    if (kind != ONLY_KIND) return;
    kind = ONLY_KIND;
#endif
    switch (kind) {
    case K_PREP_A: phase_prep_a(p, lds); break;
    case K_PREP_B: phase_prep_b(p); break;
    case K_A_IN: phase_attn_in(p, j, lds); break;
    case K_A_ATT: for (int it = blockIdx.x; it < 1056; it += gridDim.x) attn_item(p, j, it, lds); break;
    case K_OUT: phase_gemm_y(p, (const bf16*)(p.ws + S_MIX), 1024, (const bf16*)(p.ws + OFF_WTS) + W_OUT, 1024, need_ctx, lds); break;
    case K_LN1: phase_ln(p, l, 0, nrows); break;
    case K_UP: phase_up(p, l, need_ctx, lds); break;
    case K_DOWN: phase_gemm_y(p, (const bf16*)(p.ws + S_A2), DFF, (const bf16*)(p.ws + OFF_WTS) + W_DOWN, DFF, need_ctx, lds); break;
    case K_LN2:
        phase_ln(p, l, 1, nrows);
        if (l < 3) { const int nc = conv_count(l + 1); for (int it = blockIdx.x; it < nc; it += gridDim.x) convert_item(p, l + 1, it, lds); }
        break;
    case K_G_IN: phase_gla_in(p, lds); break;
    case K_G_INTRA: for (int it = blockIdx.x; it < 264 * 4; it += gridDim.x) gla_intra_item(p, j, it, lds); break;
    case K_G_SCAN: for (int it = blockIdx.x; it < 64 * NSEG; it += gridDim.x) gla_scan_item(p, it, 0, need_ctx, lds); break;
    case K_G_SCAN2: for (int it = blockIdx.x; it < 64 * NSEG; it += gridDim.x) gla_scan_item(p, it, 1, need_ctx, lds); break;
    case K_G_COMB: phase_gla_comb(p, j, nrows); break;
    }
}

__global__ void __launch_bounds__(NTHREADS, 2) mega(Params p, int ph_lo, int ph_hi) {
    extern __shared__ __attribute__((aligned(16))) unsigned char lds[];
    volatile LAS unsigned* st = (volatile LAS unsigned*)(lds + LDS_BYTES);
    if (__builtin_amdgcn_workitem_id_x() == 0) { st[0] = 0u; st[1] = 0u; st[2] = 0u; st[3] = 0u; }
    __syncthreads();
    XcdBarrier xb = xcd_barrier_post((unsigned*)(p.ws + OFF_BAR), st);
    for (int ph = ph_lo; ph < ph_hi; ++ph) {
        run_phase(p, ph, lds);
#if PROBE_KIND >= 0
        { int kind, l; phase_decode(ph, kind, l); if (kind == PROBE_KIND) { xcd_barrier(xb); run_phase(p, ph, lds); } }
#endif
        if (ph + 1 < ph_hi) xcd_barrier(xb);
    }
}

extern "C" void kernel_launch(void* const* d_in, const int* in_sizes, int n_in, void* d_out, int out_size, void* d_ws, size_t ws_size, hipStream_t stream) {
    static int grid = 0;
    if (grid == 0) {
        if (n_in != 23 || ws_size < WS_END) { fprintf(stderr, "kernel_launch: need 23 inputs and %zu ws bytes; got %d, %zu\n", (size_t)WS_END, n_in, ws_size); grid = -1; return; }
        int dev = 0, cus = 0, per_cu = 0;
        (void)hipGetDevice(&dev);
        (void)hipDeviceGetAttribute(&cus, hipDeviceAttributeMultiprocessorCount, dev);
        if (hipFuncSetAttribute((const void*)mega, hipFuncAttributeMaxDynamicSharedMemorySize, LDS_BYTES + 16) != hipSuccess) { fprintf(stderr, "hipFuncSetAttribute failed\n"); grid = -1; return; }
        if (hipOccupancyMaxActiveBlocksPerMultiprocessor(&per_cu, (const void*)mega, NTHREADS, LDS_BYTES + 16) != hipSuccess || per_cu < 1) { fprintf(stderr, "occupancy query failed (%d)\n", per_cu); grid = -1; return; }
        if (per_cu > 2) per_cu = 2;
        grid = cus * per_cu;
        fprintf(stderr, "kernel_launch: cus %d per_cu %d grid %d ws %zu need %zu\n", cus, per_cu, grid, ws_size, (size_t)WS_END);
    }
    if (grid < 0) return;
    Params p{};
    const float** pp = (const float**)&p;
    for (int i = 0; i < 23; ++i) pp[i] = (const float*)d_in[i];
    p.out = (float*)d_out; p.ws = (unsigned char*)d_ws;
    (void)hipMemsetAsync((unsigned char*)d_ws + OFF_BAR, 0, 16384 + 8192, stream);
#if SINGLE_LAUNCH
    int lo = 0, hi = NPHASES;
    void* args[] = {&p, &lo, &hi};
    hipError_t e = hipLaunchCooperativeKernel((const void*)mega, dim3(grid), dim3(NTHREADS), args, LDS_BYTES + 16, stream);
    if (e != hipSuccess) fprintf(stderr, "cooperative launch failed: %s (grid %d)\n", hipGetErrorString(e), grid);
#else
    for (int ph = 0; ph < NPHASES; ++ph) hipLaunchKernelGGL(mega, dim3(grid), dim3(NTHREADS), LDS_BYTES + 16, stream, p, ph, ph + 1);
#endif
}
```

```cpp
#include <hip/hip_runtime.h>
#include <hip/hip_cooperative_groups.h>
#include <cstdio>
#include <cstdint>
namespace cg = cooperative_groups;

#ifndef PROBE_KIND
#define PROBE_KIND -1
#endif
#ifndef SINGLE_LAUNCH
#define SINGLE_LAUNCH 1
#endif

#define DI __device__ __forceinline__
typedef unsigned short bf16;
typedef short bf16x8 __attribute__((ext_vector_type(8)));
typedef short s16x4 __attribute__((ext_vector_type(4)));
typedef float f32x16 __attribute__((ext_vector_type(16)));
typedef float f32x4 __attribute__((ext_vector_type(4)));
typedef unsigned u32x4 __attribute__((ext_vector_type(4)));
typedef unsigned u32x2 __attribute__((ext_vector_type(2)));

#define MFMA32(a, b, c) __builtin_amdgcn_mfma_f32_32x32x16_bf16((a), (b), (c), 0, 0, 0)
#define MFMA16(a, b, c) __builtin_amdgcn_mfma_f32_16x16x32_bf16((a), (b), (c), 0, 0, 0)

constexpr int TL = 16384, TA = 16896, DM = 1024, DFF = 2816;
constexpr int VTLD = 8448;
constexpr float ALPHA = 1.681792830507429f;
constexpr float EPS = 1e-6f;
constexpr int NTHREADS = 256;
constexpr int LDS_BYTES = 73728;

constexpr size_t OFF_H = 0;
constexpr size_t OFF_ABF = OFF_H + (size_t)TA * 1024 * 4;
constexpr size_t OFF_WTS = OFF_ABF + (size_t)TA * 1024 * 2;
constexpr size_t W_IN = 0, W_OUT = 3276800, W_UP = 4325376, W_DOWN = 10092544, W_END = 12976128;
constexpr size_t OFF_MOD = OFF_WTS + W_END * 2;
constexpr size_t OFF_COS = OFF_MOD + 4 * 3 * 6144 * 4;
constexpr size_t OFF_SIN = OFF_COS + 8192 * 64 * 4;
constexpr size_t OFF_SCR = OFF_SIN + 8192 * 64 * 4;
constexpr size_t S_Y = OFF_SCR;
constexpr size_t S_QK = S_Y;
constexpr size_t S_VT = S_QK + (size_t)TA * 1536 * 2;
constexpr size_t S_QH = S_Y;
constexpr size_t S_OI = S_QH + (size_t)TA * 1024 * 2;
constexpr size_t S_A2 = S_Y + (size_t)TA * 1024 * 4;
constexpr size_t S_QKR = S_A2;
constexpr size_t S_VTG = S_QKR + (size_t)TA * 1024 * 2;
constexpr size_t S_LOW = S_VTG + (size_t)TA * 1024 * 2;
constexpr size_t S_EXPL = S_LOW + (size_t)TA * 32 * 4;
constexpr size_t S_SLOC = S_EXPL + 2 * 264 * 512 * 4;
constexpr size_t S_DSEG = S_SLOC + (size_t)64 * 8 * 8192 * 4;
constexpr size_t S_MIX = S_A2 + (size_t)TA * 2816 * 2;
constexpr size_t S_OB = S_MIX + (size_t)TA * 1024 * 2;
constexpr size_t OFF_BAR = S_OB + (size_t)TA * 1024 * 2;
constexpr size_t OFF_ZERO = OFF_BAR + 16384;
constexpr size_t WS_END = OFF_ZERO + 8192;
static_assert(S_DSEG + 64 * 8 * 128 * 4 <= S_MIX, "gla scratch overflow");

struct Params {
    const float *x, *c, *ctx, *c_ctx, *ada_w, *ada_b, *ln_g, *ln_b, *up_w, *conv_w, *conv_b, *down_w;
    const float *a_win, *a_qn, *a_kn, *a_sink, *a_wout, *g_win, *g_wa1, *g_wa2, *g_ba, *g_hn, *g_wout;
    float* out;
    unsigned char* ws;
};

DI int tidx() { int t = __builtin_amdgcn_workitem_id_x(); asm volatile("" : "+v"(t)); return t; }
typedef float f32x2 __attribute__((ext_vector_type(2)));
typedef __bf16 hbf16x2 __attribute__((ext_vector_type(2)));
DI unsigned pack2(float a, float b) { f32x2 v = {a, b}; return __builtin_bit_cast(unsigned, __builtin_convertvector(v, hbf16x2)); }
DI bf16 f2bf(float x) { return (bf16)(pack2(x, 0.f) & 0xffffu); }
DI float bf2f(bf16 b) { return __uint_as_float(((unsigned)b) << 16); }
DI bf16x8 pack8(float a0, float a1, float a2, float a3, float a4, float a5, float a6, float a7) {
    u32x4 p; p.x = pack2(a0, a1); p.y = pack2(a2, a3); p.z = pack2(a4, a5); p.w = pack2(a6, a7);
    return __builtin_bit_cast(bf16x8, p);
}
DI bf16x8 join4(s16x4 lo, s16x4 hi) { bf16x8 r; r[0] = lo[0]; r[1] = lo[1]; r[2] = lo[2]; r[3] = lo[3]; r[4] = hi[0]; r[5] = hi[1]; r[6] = hi[2]; r[7] = hi[3]; return r; }
DI float wave_sum(float v) {
#pragma unroll
    for (int o = 32; o > 0; o >>= 1) v += __shfl_xor(v, o);
    return v;
}
DI float silu(float x) { return x / (1.f + __expf(-x)); }


#define XB_TMO      128
#define XB_XCNT(j)  (256  + 64 * (j))
#define XB_XSUB(j)  (1280 + 64 * (j))
#define XB_XGEN(j)  (2304 + 64 * (j))
#define XB_TOP      3328
#define XB_TOPGEN   3392
#define XCD_BAR_WORDS 3456
#define XB_SPIN_CAP (1u << 22)
#define LAS __attribute__((address_space(3)))
DI unsigned xb_ld(unsigned* p) { return __hip_atomic_load(p, __ATOMIC_RELAXED, __HIP_MEMORY_SCOPE_AGENT); }
DI unsigned xb_add(unsigned* p, unsigned v) { return __hip_atomic_fetch_add(p, v, __ATOMIC_RELAXED, __HIP_MEMORY_SCOPE_AGENT); }
DI unsigned xb_xcc_id() { return (unsigned)__builtin_amdgcn_s_getreg((3 << 11) | 20) & 0xFu; }
#define XB_SPIN(cond, bar) do { unsigned _sp = 0; while (cond) { __builtin_amdgcn_s_sleep(1); \
    if ((++_sp & 255u) == 0u) { if (xb_ld(&(bar)[XB_TMO])) break; if (_sp > XB_SPIN_CAP) { atomicAdd(&(bar)[XB_TMO], 1u); break; } } } } while (0)
struct XcdBarrier { unsigned* bar; unsigned x; volatile LAS unsigned* st; };
DI XcdBarrier xcd_barrier_post(unsigned* bar, volatile LAS unsigned* st) {
    XcdBarrier b; b.bar = bar; b.x = xb_xcc_id(); b.st = st;
    if (__builtin_amdgcn_workitem_id_x() == 0) (void)xb_add(&bar[XB_XCNT(b.x)], 1u);
    return b;
}
DI void xcd_barrier_complete(unsigned* bar, unsigned x, unsigned& nloc, unsigned& nx) {
    const unsigned G = gridDim.x;
    unsigned sum, cnt, mine, sp = 0u;
    for (;;) {
        sum = 0u; cnt = 0u; mine = 0u;
#pragma unroll
        for (unsigned j = 0; j < 16; ++j) { const unsigned c = xb_ld(&bar[XB_XCNT(j)]); sum += c; cnt += (c > 0u) ? 1u : 0u; mine = (j == x) ? c : mine; }
        if (sum == G) break;
        __builtin_amdgcn_s_sleep(1);
        if ((++sp & 255u) == 0u) { if (xb_ld(&bar[XB_TMO])) break; if (sp > XB_SPIN_CAP) { atomicAdd(&bar[XB_TMO], 1u); break; } }
    }
    nloc = mine > 0u ? mine : 1u; nx = cnt > 0u ? cnt : 1u;
}
DI void xcd_barrier(const XcdBarrier& b) {
    asm volatile("s_waitcnt vmcnt(0)" ::: "memory");
    __syncthreads();
    if (__builtin_amdgcn_workitem_id_x() == 0) {
        unsigned* bar = b.bar;
        __builtin_amdgcn_s_waitcnt(0);
        unsigned nloc = b.st[0], nx = b.st[1];
        if (nloc == 0u) { xcd_barrier_complete(bar, b.x, nloc, nx); b.st[0] = nloc; b.st[1] = nx; }
        const unsigned old = xb_add(&bar[XB_XSUB(b.x)], 1u);
        const unsigned gen = old / nloc;
        if (old + 1u == (gen + 1u) * nloc) {
            __builtin_amdgcn_fence(__ATOMIC_RELEASE, "agent");
            asm volatile("s_waitcnt vmcnt(0)" ::: "memory");
            const unsigned og = xb_add(&bar[XB_TOP], 1u);
            const unsigned tg = og / nx;
            if (og + 1u == (tg + 1u) * nx) xb_add(&bar[XB_TOPGEN], 1u);
            else XB_SPIN(xb_ld(&bar[XB_TOPGEN]) == tg, bar);
            __builtin_amdgcn_fence(__ATOMIC_ACQUIRE, "agent");
            xb_add(&bar[XB_XGEN(b.x)], 1u);
            asm volatile("s_waitcnt vmcnt(0)" ::: "memory");
        } else {
            XB_SPIN(xb_ld(&bar[XB_XGEN(b.x)]) == gen, bar);
            __builtin_amdgcn_fence(__ATOMIC_ACQUIRE, "agent");
            asm volatile("s_waitcnt vmcnt(0)" ::: "memory");
        }
    }
    __syncthreads();
}

constexpr int LDS_LD = 72;
struct ARowPlain { const bf16* base; int ld; DI const bf16* operator()(int r) const { return base + (size_t)r * ld; } };
struct ARowHalo { const bf16* base; int ld, pos0, len;
    DI const bf16* operator()(int r) const { int pp = pos0 + r; return (pp >= 0 && pp < len) ? base + (size_t)pp * ld : nullptr; } };

#define RAW_BARRIER() do { asm volatile("s_waitcnt lgkmcnt(0)" ::: "memory"); __builtin_amdgcn_s_barrier(); } while (0)
template <class AR>
DI void gemm_tile(const AR& ar, const bf16* __restrict__ Bt, int ldb, int K, f32x16 (&acc)[2][2], unsigned char* lds, const bf16* zbuf) {
    const int tid = tidx(), lane = tid & 63, w = tid >> 6, wm = w >> 1, wn = w & 1, l32 = lane & 31, hh = lane >> 5;
    const bf16* ap[4]; const bf16* bp[4];
#pragma unroll
    for (int i = 0; i < 4; ++i) {
        const int r = 32 * w + 8 * i + (lane >> 3), lc = (lane & 7) ^ ((r >> 1) & 7);
        const bf16* a = ar(r); ap[i] = (a ? a : zbuf) + lc * 8; bp[i] = Bt + (size_t)r * ldb + lc * 8;
    }
#pragma unroll
    for (int mi = 0; mi < 2; ++mi)
#pragma unroll
        for (int ni = 0; ni < 2; ++ni)
#pragma unroll
            for (int i = 0; i < 16; ++i) acc[mi][ni][i] = 0.f;
    const int wbase = w * 4096;
#define GEMM_ISSUE(stage, k0)                                                                                   \
    do {                                                                                                        \
        _Pragma("unroll") for (int i = 0; i < 4; ++i) {                                                         \
            __builtin_amdgcn_global_load_lds((const unsigned*)(ap[i] + (k0)), (LAS unsigned*)(lds + (stage) * 32768 + wbase + i * 1024), 16, 0, 0);          \
            __builtin_amdgcn_global_load_lds((const unsigned*)(bp[i] + (k0)), (LAS unsigned*)(lds + (stage) * 32768 + 16384 + wbase + i * 1024), 16, 0, 0);  \
        }                                                                                                       \
    } while (0)
    const int nk = K >> 6;
    const int key = (l32 >> 1) & 7;
    GEMM_ISSUE(0, 0);
    for (int j = 0; j < nk; ++j) {
        asm volatile("s_waitcnt vmcnt(0)" ::: "memory");
        RAW_BARRIER();
        if (j + 1 < nk) GEMM_ISSUE((j + 1) & 1, (j + 1) * 64);
        const unsigned char* As = lds + (j & 1) * 32768; const unsigned char* Bs = As + 16384;
        bf16x8 a[2][2], b[2][2];
#define GEMM_FRAGS(ks, buf)                                                                            \
        do {                                                                                           \
            const int pc = ((2 * (ks) + hh) ^ key) * 16;                                               \
            _Pragma("unroll") for (int mi = 0; mi < 2; ++mi) a[buf][mi] = *(const bf16x8*)(As + (64 * wm + 32 * mi + l32) * 128 + pc); \
            _Pragma("unroll") for (int ni = 0; ni < 2; ++ni) b[buf][ni] = *(const bf16x8*)(Bs + (64 * wn + 32 * ni + l32) * 128 + pc); \
        } while (0)
        GEMM_FRAGS(0, 0);
#pragma unroll
        for (int ks = 0; ks < 4; ++ks) {
            if (ks < 3) GEMM_FRAGS(ks + 1, (ks + 1) & 1);
#pragma unroll
            for (int mi = 0; mi < 2; ++mi)
#pragma unroll
                for (int ni = 0; ni < 2; ++ni) acc[mi][ni] = MFMA32(a[ks & 1][mi], b[ks & 1][ni], acc[mi][ni]);
        }
#undef GEMM_FRAGS
    }
#undef GEMM_ISSUE
    RAW_BARRIER();
}
DI bool xcd_tile(int iter, int MT, int NT, int& mt, int& nt) {
    const int x = blockIdx.x & 7, li = blockIdx.x >> 3, per = gridDim.x >> 3;
    const int base = MT >> 3, rem_tiles = (MT - 8 * base) * NT, extra = (rem_tiles + 7) >> 3;
    const int m_lo = x * base;
    int t = li + per * iter;
    if (t < base * NT) {
        const int nfull = NT >> 3, gsz = base * 8;
        if (t < nfull * gsz) { const int g = t / gsz, r = t - g * gsz; mt = m_lo + (r >> 3); nt = 8 * g + (r & 7); }
        else { const int r = t - nfull * gsz, wdt = NT - 8 * nfull; mt = m_lo + r / wdt; nt = 8 * nfull + r % wdt; }
        return true;
    }
    t -= base * NT;
    if (t >= extra) return false;
    const int e = x * extra + t;
    if (e >= rem_tiles) return false;
    mt = 8 * base + e / NT; nt = e % NT;
    return true;
}
constexpr int ELD = 129;
DI void stage_acc(const f32x16 (&acc)[2][2], unsigned char* lds) {
    const int tid = tidx(), lane = tid & 63, w = tid >> 6, wm = w >> 1, wn = w & 1, l32 = lane & 31, hh = lane >> 5;
    float* E = (float*)lds;
#pragma unroll
    for (int mi = 0; mi < 2; ++mi)
#pragma unroll
        for (int ni = 0; ni < 2; ++ni)
#pragma unroll
            for (int i = 0; i < 16; ++i) {
                const int row = 64 * wm + 32 * mi + 8 * (i >> 2) + 4 * hh + (i & 3), col = 64 * wn + 32 * ni + l32;
                E[row * ELD + col] = acc[mi][ni][i];
            }
    __syncthreads();
}
DI void store_acc_f32(const f32x16 (&acc)[2][2], float* Y, int ldy) {
    const int tid = tidx(), lane = tid & 63, w = tid >> 6, wm = w >> 1, wn = w & 1, l32 = lane & 31, hh = lane >> 5;
#pragma unroll
    for (int mi = 0; mi < 2; ++mi)
#pragma unroll
        for (int ni = 0; ni < 2; ++ni)
#pragma unroll
            for (int i = 0; i < 16; ++i) {
                const int row = 64 * wm + 32 * mi + 8 * (i >> 2) + 4 * hh + (i & 3), col = 64 * wn + 32 * ni + l32;
                Y[(size_t)row * ldy + col] = acc[mi][ni][i];
            }
}

DI void conv_tile(const float* __restrict__ src, int ld, int N, int k0, int n0, bf16* __restrict__ dst, int ldd, int mode, int row_off, unsigned char* lds) {
    float* Tt = (float*)lds;
    const int tid = tidx();
#pragma unroll
    for (int i = 0; i < 4; ++i) {
        const int r = (tid >> 4) + 16 * i, c4 = (tid & 15) * 4;
        f32x4 v = {0.f, 0.f, 0.f, 0.f};
        if (n0 + c4 + 3 < N) v = *(const f32x4*)(src + (size_t)(k0 + r) * ld + n0 + c4);
        Tt[r * 65 + c4 + 0] = v[0]; Tt[r * 65 + c4 + 1] = v[1]; Tt[r * 65 + c4 + 2] = v[2]; Tt[r * 65 + c4 + 3] = v[3];
    }
    __syncthreads();
    {
        const int n = tid >> 2, kq = tid & 3;
        if (n0 + n < N) {
            unsigned pk[8];
#pragma unroll
            for (int e = 0; e < 8; ++e) pk[e] = pack2(Tt[(16 * kq + 2 * e) * 65 + n], Tt[(16 * kq + 2 * e + 1) * 65 + n]);
            int cidx = n0 + n, drow;
            if (mode == 1) { const int f = cidx % DFF, isv = cidx / DFF; drow = (f >> 6) * 128 + isv * 64 + (f & 63); } else drow = cidx + row_off;
            u32x4* d = (u32x4*)(dst + (size_t)drow * ldd + k0 + 16 * kq);
            d[0] = (u32x4){pk[0], pk[1], pk[2], pk[3]}; d[1] = (u32x4){pk[4], pk[5], pk[6], pk[7]};
        }
    }
    __syncthreads();
}
DI int conv_count(int l) { return ((l & 1) ? 768 + 32 : 512) + 256 + 1408 + 704; }
DI void convert_item(const Params& p, int l, int it, unsigned char* lds) {
    const int j = l >> 1; const bool gla = l & 1; bf16* W = (bf16*)(p.ws + OFF_WTS);
    const int n_in = gla ? 768 : 512;
    if (it < n_in) {
        const int NT = gla ? 48 : 32, N = gla ? 3072 : 2048;
        const float* src = gla ? p.g_win + (size_t)j * 1024 * 3072 : p.a_win + (size_t)j * 1024 * 2048;
        conv_tile(src, N, N, (it / NT) * 64, (it % NT) * 64, W + W_IN, 1024, 0, 0, lds); return;
    }
    it -= n_in;
    if (gla) {
        if (it < 32) { const int z = it >> 4, kt = it & 15; conv_tile(p.g_wa1 + (size_t)((j * 2 + z) * 1024) * 16, 16, 16, kt * 64, 0, W + W_IN, 1024, 0, 3072 + z * 16, lds); return; }
        it -= 32;
    }
    if (it < 256) { const float* src = gla ? p.g_wout + (size_t)j * 1024 * 1024 : p.a_wout + (size_t)j * 1024 * 1024; conv_tile(src, 1024, 1024, (it >> 4) * 64, (it & 15) * 64, W + W_OUT, 1024, 0, 0, lds); return; }
    it -= 256;
    if (it < 1408) { conv_tile(p.up_w + (size_t)l * 1024 * 5632, 5632, 5632, (it / 88) * 64, (it % 88) * 64, W + W_UP, 1024, 1, 0, lds); return; }
    it -= 1408;
    conv_tile(p.down_w + (size_t)l * 2816 * 1024, 1024, 1024, (it >> 4) * 64, (it & 15) * 64, W + W_DOWN, 2816, 0, 0, lds);
}

DI void mod_item(const Params& p, int it, unsigned char* lds) {
    const int l = it / 96, j0 = (it % 96) * 64, tid = tidx();
    float* sv = (float*)lds; float* red = (float*)(lds + 12288);
    for (int i = tid; i < 3072; i += 256) { const int v = i >> 10, k = i & 1023; const float cv = v < 2 ? p.c[v * 1024 + k] : p.c_ctx[k]; sv[i] = cv / (1.f + expf(-cv)); }
    __syncthreads();
    const int cl = tid & 63, kg = tid >> 6;
    const float* wp = p.ada_w + (size_t)l * 1024 * 6144 + (size_t)(kg * 256) * 6144 + j0 + cl;
    float a0 = 0.f, a1 = 0.f, a2 = 0.f;
#pragma unroll 32
    for (int k = 0; k < 256; ++k) { const float wv = wp[(size_t)k * 6144]; a0 += sv[kg * 256 + k] * wv; a1 += sv[1024 + kg * 256 + k] * wv; a2 += sv[2048 + kg * 256 + k] * wv; }
    red[(kg * 3 + 0) * 64 + cl] = a0; red[(kg * 3 + 1) * 64 + cl] = a1; red[(kg * 3 + 2) * 64 + cl] = a2;
    __syncthreads();
    if (tid < 192) {
        const int v = tid >> 6; float s = 0.f;
#pragma unroll
        for (int g = 0; g < 4; ++g) s += red[(g * 3 + v) * 64 + cl];
        ((float*)(p.ws + OFF_MOD))[(l * 3 + v) * 6144 + j0 + cl] = s + p.ada_b[l * 6144 + j0 + cl];
    }
    __syncthreads();
}
DI void phase_prep_a(const Params& p, unsigned char* lds) {
    const int n_mod = 384, n_rope = 512, n_conv = conv_count(0), total = n_mod + n_rope + n_conv;
    for (int it = blockIdx.x; it < total; it += gridDim.x) {
        if (it < n_mod) mod_item(p, it, lds);
        else if (it < n_mod + n_rope) {
            float* C = (float*)(p.ws + OFF_COS); float* S = (float*)(p.ws + OFF_SIN);
#pragma unroll
            for (int k = 0; k < 4; ++k) {
                const int e = (it - n_mod) * 1024 + tidx() + 256 * k, pos = e >> 6, i = e & 63, jj = i & 31;
                const float inv = powf(10000.f, -(float)jj * 2.0f / 64.0f);
                const float ang = (float)(i < 32 ? (pos >> 6) : (pos & 63)) * inv;
                C[e] = cosf(ang); S[e] = sinf(ang);
            }
        } else convert_item(p, 0, it - n_mod - n_rope, lds);
    }
}
DI int row_modv(int row) { return row < TL ? (row >> 13) : 2; }
DI void phase_prep_b(const Params& p) {
    const int lane = tidx() & 63, gw = blockIdx.x * 4 + (tidx() >> 6), nw = gridDim.x * 4;
    float* H = (float*)(p.ws + OFF_H); bf16* ABF = (bf16*)(p.ws + OFF_ABF); const float* MOD = (const float*)(p.ws + OFF_MOD);
    for (int row = gw; row < TA; row += nw) {
        const float* src = row < TL ? p.x + (size_t)row * 1024 : p.ctx + (size_t)(row - TL) * 1024;
        const float* md = MOD + (0 * 3 + row_modv(row)) * 6144;
#pragma unroll
        for (int i = 0; i < 4; ++i) {
            const int c = 4 * lane + 256 * i;
            const f32x4 v = *(const f32x4*)(src + c), sh = *(const f32x4*)(md + c), sc = *(const f32x4*)(md + 1024 + c);
            *(f32x4*)(H + (size_t)row * 1024 + c) = v;
            u32x2 o; o.x = pack2(v[0] * (1.f + sc[0]) + sh[0], v[1] * (1.f + sc[1]) + sh[1]); o.y = pack2(v[2] * (1.f + sc[2]) + sh[2], v[3] * (1.f + sc[3]) + sh[3]);
            *(u32x2*)(ABF + (size_t)row * 1024 + c) = o;
        }
    }
}
DI void phase_ln(const Params& p, int l, int which, int nrows) {
    const int lane = tidx() & 63, gw = blockIdx.x * 4 + (tidx() >> 6), nw = gridDim.x * 4;
    float* H = (float*)(p.ws + OFF_H); bf16* ABF = (bf16*)(p.ws + OFF_ABF); const float* MOD = (const float*)(p.ws + OFF_MOD);
    const float* Y = (const float*)(p.ws + S_Y); const float* P = (const float*)(p.ws + S_OB);
    const int KS = which ? 11 : 16;
    const float* lg = p.ln_g + (l * 2 + which) * 1024; const float* lb = p.ln_b + (l * 2 + which) * 1024;
    const bool last = (which == 1 && l == 3);
    for (int row = gw; row < nrows; row += nw) {
        const int mv = row_modv(row);
        const float* gate = MOD + (l * 3 + mv) * 6144 + (which ? 5 : 2) * 1024;
        const float* nsh = which ? MOD + ((l + 1) * 3 + mv) * 6144 : MOD + (l * 3 + mv) * 6144 + 3 * 1024;
        const float* nsc = nsh + 1024;
        f32x4 v[4]; float s = 0.f;
#pragma unroll
        for (int i = 0; i < 4; ++i) {
            const int c = 4 * lane + 256 * i;
            const f32x4 h = *(const f32x4*)(H + (size_t)row * 1024 + c), g = *(const f32x4*)(gate + c);
            f32x4 y;
            if (row < TL) y = *(const f32x4*)(Y + (size_t)row * 1024 + c);
            else { y = (f32x4){0.f, 0.f, 0.f, 0.f}; for (int ks = 0; ks < KS; ++ks) y += *(const f32x4*)(P + ((size_t)ks * 512 + (row - TL)) * 1024 + c); }
            v[i] = ALPHA * h + g * y; s += (v[i][0] + v[i][1]) + (v[i][2] + v[i][3]);
        }
        const float mu = wave_sum(s) * (1.f / 1024.f); float q = 0.f;
#pragma unroll
        for (int i = 0; i < 4; ++i) { const f32x4 d = v[i] - mu; q += (d[0] * d[0] + d[1] * d[1]) + (d[2] * d[2] + d[3] * d[3]); }
        const float rstd = rsqrtf(wave_sum(q) * (1.f / 1024.f) + EPS);
#pragma unroll
        for (int i = 0; i < 4; ++i) {
            const int c = 4 * lane + 256 * i;
            const f32x4 o = (v[i] - mu) * rstd * *(const f32x4*)(lg + c) + *(const f32x4*)(lb + c);
            if (last) { *(f32x4*)(p.out + (size_t)row * 1024 + c) = o; }
            else {
                *(f32x4*)(H + (size_t)row * 1024 + c) = o;
                const f32x4 sh = *(const f32x4*)(nsh + c), sc = *(const f32x4*)(nsc + c);
                u32x2 ob; ob.x = pack2(o[0] * (1.f + sc[0]) + sh[0], o[1] * (1.f + sc[1]) + sh[1]); ob.y = pack2(o[2] * (1.f + sc[2]) + sh[2], o[3] * (1.f + sc[3]) + sh[3]);
                *(u32x2*)(ABF + (size_t)row * 1024 + c) = ob;
            }
        }
    }
}

DI void phase_attn_in(const Params& p, int j, unsigned char* lds) {
    const bf16* ABF = (const bf16*)(p.ws + OFF_ABF); const bf16* W = (const bf16*)(p.ws + OFF_WTS) + W_IN;
    bf16* QK = (bf16*)(p.ws + S_QK); bf16* VT = (bf16*)(p.ws + S_VT);
    const float* COS = (const float*)(p.ws + OFF_COS); const float* SIN = (const float*)(p.ws + OFF_SIN);
    const int lane = tidx() & 63, w = tidx() >> 6;
    const bf16* ZB = (const bf16*)(p.ws + OFF_ZERO);
    for (int iter = 0;; ++iter) {
        int mt, nt; if (!xcd_tile(iter, 132, 16, mt, nt)) break;
        const int m0 = mt * 128;
        f32x16 acc[2][2];
        gemm_tile(ARowPlain{ABF + (size_t)m0 * 1024, 1024}, W + (size_t)nt * 128 * 1024, 1024, 1024, acc, lds, ZB);
        stage_acc(acc, lds);
        const float* E = (const float*)lds;
        const bool lat = mt < 128;
        const int b = lat ? (mt >> 6) : ((mt - 128) >> 1);
        const int pos0 = lat ? (mt & 63) * 128 : ((mt - 128) & 1) * 128;
        const bool isv = (nt == 6 || nt == 7 || nt >= 14);
        if (isv) {
            const int vh = nt < 8 ? nt - 6 : 2 + nt - 14;
            bf16* vb = VT + (size_t)((b * 4 + vh) * 128) * VTLD + (lat ? pos0 : 8192 + pos0);
#pragma unroll
            for (int half = 0; half < 2; ++half) {
                const int tok = 64 * half + lane;
                for (int d = w; d < 128; d += 4) vb[(size_t)d * VTLD + tok] = f2bf(E[tok * ELD + d]);
            }
        } else {
            const bool norm = nt < 6;
            const int colbase = nt < 4 ? nt * 128 : (nt < 6 ? 512 + (nt - 4) * 128 : (nt < 12 ? 768 + (nt - 8) * 128 : 1280 + (nt - 12) * 128));
            const float* gw = nt < 4 ? p.a_qn + j * 128 : p.a_kn + j * 128;
            const float g1 = norm ? gw[lane] : 1.f, g2 = norm ? gw[64 + lane] : 1.f;
            for (int rr = 0; rr < 32; ++rr) {
                const int r = 32 * w + rr;
                float x1 = E[r * ELD + lane], x2 = E[r * ELD + 64 + lane];
                if (norm) { const float ss = wave_sum(x1 * x1 + x2 * x2); const float rs = rsqrtf(ss * (1.f / 128.f) + EPS); x1 = x1 * rs * g1; x2 = x2 * rs * g2; }
                float o1 = x1, o2 = x2;
                if (lat) { const int pos = pos0 + r; const float cs = COS[pos * 64 + lane], sn = SIN[pos * 64 + lane]; o1 = x1 * cs - x2 * sn; o2 = x1 * sn + x2 * cs; }
                bf16* dst = QK + (size_t)(m0 + r) * 1536 + colbase;
                dst[lane] = f2bf(o1); dst[64 + lane] = f2bf(o2);
            }
        }
        __syncthreads();
    }
}

DI void attn_item(const Params& p, int j, int it, unsigned char* lds) {
    const int tid = tidx(), lane = tid & 63, w = tid >> 6, l32 = lane & 31, hh = lane >> 5;
    int type;
    if (it < 512) type = 0; else if (it < 1024) { type = 1; it -= 512; } else if (it < 1040) { type = 2; it -= 1024; } else { type = 3; it -= 1040; }
    int b, qh, qb;
    if (type < 2) { qb = it & 63; qh = (it >> 6) & 3; b = it >> 8; } else { qb = it & 1; qh = (it >> 1) & 3; b = it >> 3; }
    const bool win = type & 1, isctx = type >= 2;
    const int qrow0 = isctx ? TL + b * 256 + qb * 128 : b * 8192 + qb * 128;
    const int qcol = win ? 768 + qh * 128 : qh * 128;
    const int kcol = win ? 1280 + (qh >> 1) * 128 : 512 + (qh >> 1) * 128;
    const int vhead = b * 4 + (win ? 2 : 0) + (qh >> 1);
    const int ocol = (win ? 512 : 0) + qh * 128;
    const int nbk = 1 + (qb > 0 ? 1 : 0) + (qb < 63 ? 1 : 0);
    const int nlat = isctx ? 0 : (win ? 2 * nbk : 128);
    const int ntiles = nlat + 4;
    const bf16* QK = (const bf16*)(p.ws + S_QK); const bf16* VT = (const bf16*)(p.ws + S_VT) + (size_t)vhead * 128 * VTLD;
    bf16* MIX = (bf16*)(p.ws + S_MIX);
    bf16x8 qf[8];
    {
        const bf16* qp = QK + (size_t)(qrow0 + 32 * w + l32) * 1536 + qcol + 8 * hh;
#pragma unroll
        for (int ks = 0; ks < 8; ++ks) qf[ks] = *(const bf16x8*)(qp + 16 * ks);
    }
    f32x16 O[4];
#pragma unroll
    for (int mt = 0; mt < 4; ++mt)
#pragma unroll
        for (int i = 0; i < 16; ++i) O[mt][i] = 0.f;
    float m_run = -INFINITY, l_run = 0.f;
    const float cscale = 0.08838834764831845f * 1.4426950408889634f;
    const int qpos = qb * 128 + 32 * w + l32;
    int krow0, vcol0, kpos0; bool msk;
    const int k_r = lane >> 4, k_pc = lane & 15;
    const int v_r = lane >> 3, v_pc = lane & 7;
    const int kperm = (l32 & 0x13) | ((l32 & 4) << 1) | ((l32 & 8) >> 1);
#define TILE_INFO(tj)                                                                                         \
    do {                                                                                                      \
        if ((tj) < nlat) {                                                                                    \
            int kp;                                                                                           \
            if (!win) kp = (tj) * 64;                                                                         \
            else { const int bi = (tj) >> 1; const int blk = bi == 0 ? qb : (bi == 1 ? (qb > 0 ? qb - 1 : qb + 1) : qb + 1); kp = blk * 128 + ((tj) & 1) * 64; } \
            krow0 = b * 8192 + kp; vcol0 = kp; kpos0 = kp; msk = win;                                         \
        } else { const int cc = (tj) - nlat; krow0 = TL + b * 256 + cc * 64; vcol0 = 8192 + cc * 64; kpos0 = 0; msk = false; } \
    } while (0)
#define ISSUE_LOADS(stage)                                                                                    \
    do {                                                                                                      \
        _Pragma("unroll") for (int i = 0; i < 4; ++i) {                                                       \
            const int kr = 16 * w + 4 * i + k_r, vr = 32 * w + 8 * i + v_r;                                   \
            __builtin_amdgcn_global_load_lds((const unsigned*)(QK + (size_t)(krow0 + kr) * 1536 + kcol + ((k_pc ^ (kr & 15)) * 8)), (LAS unsigned*)(lds + (stage) * 32768 + w * 4096 + i * 1024), 16, 0, 0); \
            __builtin_amdgcn_global_load_lds((const unsigned*)(VT + (size_t)vr * VTLD + vcol0 + ((v_pc ^ ((vr >> 1) & 7)) * 8)), (LAS unsigned*)(lds + (stage) * 32768 + 16384 + w * 4096 + i * 1024), 16, 0, 0); \
        }                                                                                                     \
    } while (0)
    int koff[8], voff[4];
#pragma unroll
    for (int ks = 0; ks < 8; ++ks) koff[ks] = kperm * 256 + (((2 * ks + hh) ^ (kperm & 15)) * 16);
#pragma unroll
    for (int kk = 0; kk < 4; ++kk) voff[kk] = 16384 + l32 * 128 + (((2 * kk + hh) ^ ((l32 >> 1) & 7)) * 16);
    TILE_INFO(0);
    ISSUE_LOADS(0);
    for (int tj = 0; tj < ntiles; ++tj) {
        const int c_kpos0 = kpos0; const bool c_msk = msk;
        asm volatile("s_waitcnt vmcnt(0)" ::: "memory");
        RAW_BARRIER();
        if (tj + 1 < ntiles) { TILE_INFO(tj + 1); ISSUE_LOADS((tj + 1) & 1); }
        const unsigned char* Kst = lds + (tj & 1) * 32768;
        f32x16 S[2];
#pragma unroll
        for (int st = 0; st < 2; ++st)
#pragma unroll
            for (int i = 0; i < 16; ++i) S[st][i] = 0.f;
#pragma unroll
        for (int ks = 0; ks < 8; ++ks)
#pragma unroll
            for (int st = 0; st < 2; ++st) {
                const bf16x8 ak = *(const bf16x8*)(Kst + koff[ks] + st * 8192);
                S[st] = MFMA32(ak, qf[ks], S[st]);
            }
        float mx = -INFINITY;
        if (c_msk) {
#pragma unroll
            for (int st = 0; st < 2; ++st)
#pragma unroll
                for (int i = 0; i < 16; ++i) {
                    const int kp = c_kpos0 + 32 * st + 16 * (i >> 3) + 8 * hh + 4 * ((i >> 2) & 1) + (i & 3); const int df = kp - qpos;
                    if (df > 128 || df < -128) S[st][i] = -INFINITY;
                }
        }
#pragma unroll
        for (int st = 0; st < 2; ++st)
#pragma unroll
            for (int i = 0; i < 16; ++i) mx = fmaxf(mx, S[st][i]);
        mx = fmaxf(mx, __shfl_xor(mx, 32));
        if (__any((mx - m_run) * cscale > 8.f)) {
            const float m_new = fmaxf(m_run, mx);
            const float alpha = __builtin_amdgcn_exp2f((m_run - m_new) * cscale);
            m_run = m_new; l_run *= alpha;
#pragma unroll
            for (int mt = 0; mt < 4; ++mt) O[mt] = O[mt] * alpha;
        }
        const float mref = -m_run * cscale;
        float ps = 0.f;
#pragma unroll
        for (int st = 0; st < 2; ++st)
#pragma unroll
            for (int i = 0; i < 16; ++i) { const float pv = __builtin_amdgcn_exp2f(__builtin_fmaf(S[st][i], cscale, mref)); S[st][i] = pv; ps += pv; }
        l_run += ps;
        bf16x8 P[4];
#pragma unroll
        for (int kk = 0; kk < 4; ++kk) { const int st = kk >> 1, o = (kk & 1) * 8; P[kk] = pack8(S[st][o], S[st][o + 1], S[st][o + 2], S[st][o + 3], S[st][o + 4], S[st][o + 5], S[st][o + 6], S[st][o + 7]); }
#pragma unroll
        for (int mt = 0; mt < 4; ++mt)
#pragma unroll
            for (int kk = 0; kk < 4; ++kk) {
                const bf16x8 av = *(const bf16x8*)(Kst + voff[kk] + mt * 4096);
                O[mt] = MFMA32(av, P[kk], O[mt]);
            }
    }
#undef TILE_INFO
#undef ISSUE_LOADS
    RAW_BARRIER();
    float l_tot = l_run + __shfl_xor(l_run, 32);
    if (win) l_tot += __builtin_amdgcn_exp2f(p.a_sink[j * 4 + qh] * 1.4426950408889634f - m_run * cscale);
    const float inv = 1.f / l_tot;
    __syncthreads();
    bf16* Os = (bf16*)lds;
#pragma unroll
    for (int mt = 0; mt < 4; ++mt)
#pragma unroll
        for (int i = 0; i < 16; ++i) Os[(32 * w + l32) * 136 + 32 * mt + 8 * (i >> 2) + 4 * hh + (i & 3)] = f2bf(O[mt][i] * inv);
    __syncthreads();
#pragma unroll
    for (int i = 0; i < 8; ++i) {
        const int row = (tid >> 4) + 16 * i, ch = tid & 15;
        *(u32x4*)(MIX + (size_t)(qrow0 + row) * 1024 + ocol + ch * 8) = *(const u32x4*)(Os + row * 136 + ch * 8);
    }
    __syncthreads();
}

DI void phase_gemm_y(const Params& p, const bf16* A, int lda, const bf16* Bt, int K, bool need_ctx, unsigned char* lds) {
    float* Y = (float*)(p.ws + S_Y); float* P = (float*)(p.ws + S_OB);
    const bf16* ZB = (const bf16*)(p.ws + OFF_ZERO);
    if (need_ctx) {
        const int KS = (K == 1024) ? 16 : 11, klen = K / KS, items = 32 * KS;
        for (int it = blockIdx.x; it < items; it += gridDim.x) {
            const int ct = it / KS, ks = it - ct * KS, cm = ct >> 3, nt = ct & 7;
            f32x16 acc[2][2];
            gemm_tile(ARowPlain{A + (size_t)(TL + cm * 128) * lda + ks * klen, lda}, Bt + (size_t)nt * 128 * K + ks * klen, K, klen, acc, lds, ZB);
            store_acc_f32(acc, P + ((size_t)ks * 512 + cm * 128) * 1024 + nt * 128, 1024);
        }
    }
    for (int iter = 0;; ++iter) {
        int mt, nt; if (!xcd_tile(iter, 128, 8, mt, nt)) break;
        f32x16 acc[2][2];
        gemm_tile(ARowPlain{A + (size_t)mt * 128 * lda, lda}, Bt + (size_t)nt * 128 * K, K, K, acc, lds, ZB);
        store_acc_f32(acc, Y + (size_t)mt * 128 * 1024 + nt * 128, 1024);
    }
}
DI void phase_up(const Params& p, int l, bool need_ctx, unsigned char* lds) {
    const bf16* ABF = (const bf16*)(p.ws + OFF_ABF); const bf16* W = (const bf16*)(p.ws + OFF_WTS) + W_UP;
    bf16* A2 = (bf16*)(p.ws + S_A2);
    const int lane = tidx() & 63, w = tidx() >> 6;
    const int mtiles = need_ctx ? 138 : 132;
    const bf16* ZB = (const bf16*)(p.ws + OFF_ZERO);
    const float* cw = p.conv_w + (size_t)l * 3 * 5632; const float* cb = p.conv_b + (size_t)l * 5632;
    for (int iter = 0;; ++iter) {
        int mi, nt; if (!xcd_tile(iter, mtiles, 44, mi, nt)) break;
        int seqbase, len, ti;
        if (mi < 132) { seqbase = (mi / 66) * 8192; len = 8192; ti = mi % 66; } else { const int cc = mi - 132; seqbase = TL + (cc / 3) * 256; len = 256; ti = cc % 3; }
        f32x16 acc[2][2];
        gemm_tile(ARowHalo{ABF + (size_t)seqbase * 1024, 1024, 126 * ti - 1, len}, W + (size_t)nt * 128 * 1024, 1024, 1024, acc, lds, ZB);
        stage_acc(acc, lds);
        const float* E = (const float*)lds;
        const int fg = nt * 64 + lane;
        const float g0 = cw[fg], g1 = cw[5632 + fg], g2 = cw[2 * 5632 + fg], gb = cb[fg];
        const float v0 = cw[DFF + fg], v1 = cw[5632 + DFF + fg], v2 = cw[2 * 5632 + DFF + fg], vb = cb[DFF + fg];
        for (int r = 1 + w; r <= 126; r += 4) {
            const int pos = 126 * ti - 1 + r;
            if (pos < len) {
                const float G = gb + g0 * E[(r - 1) * ELD + lane] + g1 * E[r * ELD + lane] + g2 * E[(r + 1) * ELD + lane];
                const float V = vb + v0 * E[(r - 1) * ELD + 64 + lane] + v1 * E[r * ELD + 64 + lane] + v2 * E[(r + 1) * ELD + 64 + lane];
                A2[(size_t)(seqbase + pos) * DFF + fg] = f2bf(silu(G) * V);
            }
        }
        __syncthreads();
    }
}

DI void phase_gla_in(const Params& p, unsigned char* lds) {
    const bf16* ABF = (const bf16*)(p.ws + OFF_ABF); const bf16* W = (const bf16*)(p.ws + OFF_WTS) + W_IN;
    bf16* QKR = (bf16*)(p.ws + S_QKR); bf16* VTG = (bf16*)(p.ws + S_VTG); bf16* G = (bf16*)(p.ws + S_MIX); float* LOW = (float*)(p.ws + S_LOW);
    const int lane = tidx() & 63, w = tidx() >> 6;
    const bf16* ZB = (const bf16*)(p.ws + OFF_ZERO);
    for (int iter = 0;; ++iter) {
        int mt, nt; if (!xcd_tile(iter, 132, 25, mt, nt)) break;
        const int m0 = mt * 128;
        f32x16 acc[2][2];
        gemm_tile(ARowPlain{ABF + (size_t)m0 * 1024, 1024}, W + (size_t)nt * 128 * 1024, 1024, 1024, acc, lds, ZB);
        stage_acc(acc, lds);
        const float* E = (const float*)lds;
        const bool lat = mt < 128;
        const int b = lat ? (mt >> 6) : ((mt - 128) >> 1);
        const int pos0 = lat ? (mt & 63) * 128 : 8192 + ((mt - 128) & 1) * 128;
        if (nt >= 8 && nt < 16) {
            bf16* vb = VTG + (size_t)(b * 1024 + (nt - 8) * 128) * VTLD + pos0;
#pragma unroll
            for (int half = 0; half < 2; ++half) {
                const int tok = 64 * half + lane;
                for (int d = w; d < 128; d += 4) vb[(size_t)d * VTLD + tok] = f2bf(E[tok * ELD + d]);
            }
        } else if (nt == 24) {
            for (int rr = 0; rr < 32; ++rr) { const int r = 32 * w + rr; if (lane < 32) LOW[(size_t)(m0 + r) * 32 + lane] = E[r * ELD + lane]; }
        } else {
            bf16* dst0 = nt < 8 ? QKR + nt * 128 : G + (nt - 16) * 128;
            for (int rr = 0; rr < 32; ++rr) {
                const int r = 32 * w + rr;
                bf16* dst = dst0 + (size_t)(m0 + r) * 1024;
                dst[lane] = f2bf(E[r * ELD + lane]); dst[64 + lane] = f2bf(E[r * ELD + 64 + lane]);
            }
        }
        __syncthreads();
    }
}
DI float logsig(float x) { return fminf(x, 0.f) - __logf(1.f + __expf(-fabsf(x))); }

DI void gla_intra_item(const Params& p, int j, int it, unsigned char* lds) {
    const int tid = tidx(), lane = tid & 63, w = tid >> 6, l32 = lane & 31, hh = lane >> 5;
    const int h = it & 3, cidx = it >> 2;
    const int row0 = cidx * 64;
    int b, tokpos0;
    if (cidx < 256) { b = cidx >> 7; tokpos0 = (cidx & 127) * 64; } else { b = (cidx - 256) >> 2; tokpos0 = 8192 + ((cidx - 256) & 3) * 64; }
    float* Ls = (float*)lds;
    bf16* Vs = (bf16*)(lds + 8192);
    bf16* Qs = (bf16*)(lds + 8192 + 18432);
    bf16* Ks = Qs + 64 * 136;
    float* HS = (float*)(lds + 8192 + 18432 + 2 * 17408);
    const bf16* QKR = (const bf16*)(p.ws + S_QKR); const bf16* VTG = (const bf16*)(p.ws + S_VTG); const float* LOW = (const float*)(p.ws + S_LOW);
    bf16* QH = (bf16*)(p.ws + S_QH); bf16* KT = (bf16*)(p.ws + OFF_ABF); float* EXPL = (float*)(p.ws + S_EXPL); bf16* OI = (bf16*)(p.ws + S_OI);
    u32x4 rq[4], rk[4];
    {
        const f32x4* src = (const f32x4*)(LOW + (size_t)row0 * 32);
        ((f32x4*)Ls)[tid] = src[tid]; ((f32x4*)Ls)[tid + 256] = src[tid + 256];
#pragma unroll
        for (int i = 0; i < 4; ++i) {
            const bf16* qp = QKR + (size_t)(row0 + (tid >> 4) + 16 * i) * 1024 + h * 128 + (tid & 15) * 8;
            rq[i] = *(const u32x4*)qp; rk[i] = *(const u32x4*)(qp + 512);
        }
#pragma unroll
        for (int i = 0; i < 4; ++i) {
            *(u32x4*)(Qs + ((tid >> 4) + 16 * i) * 136 + (tid & 15) * 8) = rq[i];
            *(u32x4*)(Ks + ((tid >> 4) + 16 * i) * 136 + (tid & 15) * 8) = rk[i];
        }
    }
    __syncthreads();
    const int d = tid & 127, rh = tid >> 7;
    const int tt = w & 1, nq = w >> 1;
    bf16x8 P[2][4];
#pragma unroll
    for (int dir = 0; dir < 2; ++dir) {
        float w2[16];
#pragma unroll
        for (int r = 0; r < 16; ++r) w2[r] = p.g_wa2[(size_t)((j * 2 + dir) * 16 + r) * 512 + h * 128 + d];
        const float bias = p.g_ba[(j * 2 + dir) * 512 + h * 128 + d];
        float ld[32]; float hs = 0.f;
#pragma unroll
        for (int i = 0; i < 32; ++i) {
            const float* lr = Ls + (32 * rh + i) * 32 + dir * 16;
            float x = bias;
#pragma unroll
            for (int r = 0; r < 16; ++r) x += lr[r] * w2[r];
            const float v = logsig(x) * 0.0625f; ld[i] = v; hs += v;
        }
        HS[rh * 128 + d] = hs;
        __syncthreads();
        const float other = HS[(1 - rh) * 128 + d];
        float run = (dir == 0) ? (rh ? other : 0.f) : (rh ? 0.f : other);
#pragma unroll
        for (int ii = 0; ii < 32; ++ii) {
            const int i = dir == 0 ? ii : 31 - ii;
            const int r = 32 * rh + i;
            run += ld[i];
            const float eq = __expf(run);
            const bf16 qv = f2bf(bf2f(Qs[r * 136 + d]) * eq * 0.08838834764831845f), kv = f2bf(bf2f(Ks[r * 136 + d]) * __builtin_amdgcn_rcpf(eq));
            Qs[r * 136 + d] = qv; Ks[r * 136 + d] = kv;
            QH[((size_t)dir * TA + row0 + r) * 512 + h * 128 + d] = qv;
        }
        if (rh == 0) EXPL[(size_t)(dir * 264 + cidx) * 512 + h * 128 + d] = __expf(hs + other);
        __syncthreads();
        {
            const int dd = tid >> 1, sh = tid & 1; unsigned pk[16];
#pragma unroll
            for (int e = 0; e < 16; ++e) pk[e] = (unsigned)Ks[(32 * sh + 2 * e) * 136 + dd] | ((unsigned)Ks[(32 * sh + 2 * e + 1) * 136 + dd] << 16);
            u32x4* dst = (u32x4*)(KT + ((size_t)(dir * 264 + cidx) * 512 + h * 128 + dd) * 64 + 32 * sh);
            dst[0] = (u32x4){pk[0], pk[1], pk[2], pk[3]}; dst[1] = (u32x4){pk[4], pk[5], pk[6], pk[7]};
            dst[2] = (u32x4){pk[8], pk[9], pk[10], pk[11]}; dst[3] = (u32x4){pk[12], pk[13], pk[14], pk[15]};
        }
        f32x16 AT[2];
#pragma unroll
        for (int st = 0; st < 2; ++st)
#pragma unroll
            for (int i = 0; i < 16; ++i) AT[st][i] = 0.f;
#pragma unroll
        for (int ks = 0; ks < 8; ++ks) {
            const bf16x8 bq = *(const bf16x8*)(Qs + (32 * tt + l32) * 136 + 16 * ks + 8 * hh);
#pragma unroll
            for (int st = 0; st < 2; ++st) { const bf16x8 ak = *(const bf16x8*)(Ks + (32 * st + l32) * 136 + 16 * ks + 8 * hh); AT[st] = MFMA32(ak, bq, AT[st]); }
        }
        const int t = 32 * tt + l32;
#pragma unroll
        for (int kk = 0; kk < 4; ++kk) {
            const int st = kk >> 1; float v[8];
#pragma unroll
            for (int e = 0; e < 8; ++e) {
                const int i = (kk & 1) * 8 + e; const int sidx = 32 * st + 8 * (i >> 2) + 4 * hh + (i & 3);
                const bool keep = dir == 0 ? (sidx <= t) : (sidx >= t);
                v[e] = keep ? AT[st][i] : 0.f;
            }
            P[dir][kk] = pack8(v[0], v[1], v[2], v[3], v[4], v[5], v[6], v[7]);
        }
        __syncthreads();
        if (dir == 0) {
#pragma unroll
            for (int i = 0; i < 4; ++i) {
                *(u32x4*)(Qs + ((tid >> 4) + 16 * i) * 136 + (tid & 15) * 8) = rq[i];
                *(u32x4*)(Ks + ((tid >> 4) + 16 * i) * 136 + (tid & 15) * 8) = rk[i];
            }
            __syncthreads();
        }
    }
    bf16* OT = Qs;
#pragma unroll 1
    for (int nh = 0; nh < 2; ++nh) {
#pragma unroll
        for (int i = 0; i < 4; ++i) {
            const int n = (tid >> 3) + 32 * i, ch = tid & 7;
            *(u32x4*)(Vs + n * 72 + ch * 8) = *(const u32x4*)(VTG + (size_t)(b * 1024 + h * 256 + nh * 128 + n) * VTLD + tokpos0 + ch * 8);
        }
        __syncthreads();
        f32x16 O[2];
#pragma unroll
        for (int mt = 0; mt < 2; ++mt)
#pragma unroll
            for (int i = 0; i < 16; ++i) O[mt][i] = 0.f;
#pragma unroll
        for (int mt = 0; mt < 2; ++mt)
#pragma unroll
            for (int kk = 0; kk < 4; ++kk) {
                const bf16* vp = Vs + (64 * nq + 32 * mt + l32) * 72 + 16 * kk + 4 * hh;
                const bf16x8 av = join4(*(const s16x4*)vp, *(const s16x4*)(vp + 8));
                O[mt] = MFMA32(av, P[0][kk], O[mt]); O[mt] = MFMA32(av, P[1][kk], O[mt]);
            }
#pragma unroll
        for (int mt = 0; mt < 2; ++mt)
#pragma unroll
            for (int i = 0; i < 16; ++i) OT[(32 * tt + l32) * 136 + 64 * nq + 32 * mt + 8 * (i >> 2) + 4 * hh + (i & 3)] = f2bf(O[mt][i]);
        __syncthreads();
#pragma unroll
        for (int i = 0; i < 4; ++i) {
            const int row = (tid >> 4) + 16 * i, ch = tid & 15;
            *(u32x4*)(OI + (size_t)(row0 + row) * 1024 + h * 256 + nh * 128 + ch * 8) = *(const u32x4*)(OT + row * 136 + ch * 8);
        }
        __syncthreads();
    }
}

constexpr int NSEG = 8, SEGLEN = 17;
DI void gla_scan_item(const Params& p, int it, int mode, bool write_ctx, unsigned char* lds) {
    const int tid = tidx(), lane = tid & 63, w = tid >> 6, l16 = lane & 15, g = lane >> 4;
    const int seg = it & 7, cs = it >> 3, slice = cs & 3, chain = cs >> 2, dir = chain & 1, h = (chain >> 1) & 3, b = chain >> 3;
    if (mode == 0 && seg == NSEG - 1) return;
    const int s0 = seg * SEGLEN, s1 = (s0 + SEGLEN < 132) ? s0 + SEGLEN : 132;
    bf16* Qs = (bf16*)lds;
    bf16* KTs = (bf16*)(lds + 17408);
    bf16* Vs = (bf16*)(lds + 17408 + 18432);
    float* Es = (float*)(lds + 17408 + 18432 + 9216);
    const bf16* QH = (const bf16*)(p.ws + S_QH); const bf16* KT = (const bf16*)(p.ws + OFF_ABF); const bf16* VTG = (const bf16*)(p.ws + S_VTG);
    const float* EXPL = (const float*)(p.ws + S_EXPL);
    float* SLOC = (float*)(p.ws + S_SLOC); float* DSEG = (float*)(p.ws + S_DSEG);
    bf16* OUT = (bf16*)(p.ws + (dir ? S_OB : S_QKR));
    f32x4 S[8];
#pragma unroll
    for (int mt = 0; mt < 8; ++mt) S[mt] = (f32x4){0.f, 0.f, 0.f, 0.f};
    if (mode) {
        for (int sp = 0; sp < seg; ++sp) {
#pragma unroll
            for (int mt = 0; mt < 8; ++mt) {
                const f32x4 dd = *(const f32x4*)(DSEG + (size_t)(cs * NSEG + sp) * 128 + 16 * mt + 4 * g);
                const f32x4 sl = *(const f32x4*)(SLOC + ((((size_t)(cs * NSEG + sp) * 4 + w) * 8 + mt) * 64 + lane) * 4);
                S[mt] = S[mt] * dd + sl;
            }
        }
    }
    float dprod = 1.f;
    u32x4 rqA[4], rkA[4], rvA[2], rqB[4], rkB[4], rvB[2]; float reA = 0.f, reB = 0.f;
    int cidx, tokpos0, rowA = 0, rowB = 0;
#define CHUNK_OF(step)                                                                           \
    do {                                                                                         \
        if ((step) < 4) { const int c = dir ? 3 - (step) : (step); cidx = 256 + b * 4 + c; tokpos0 = 8192 + c * 64; } \
        else { int c = (step) - 4; c = dir ? 127 - c : c; cidx = b * 128 + c; tokpos0 = c * 64; } \
    } while (0)
#define SCAN_ISSUE(RQ, RK, RV, RE)                                                               \
    do {                                                                                         \
        _Pragma("unroll") for (int i = 0; i < 4; ++i) {                                          \
            if (mode) RQ[i] = *(const u32x4*)(QH + ((size_t)dir * TA + cidx * 64 + (tid >> 4) + 16 * i) * 512 + h * 128 + (tid & 15) * 8); \
            RK[i] = *(const u32x4*)(KT + ((size_t)(dir * 264 + cidx) * 512 + h * 128 + (tid >> 3) + 32 * i) * 64 + (tid & 7) * 8); \
        }                                                                                        \
        _Pragma("unroll") for (int i = 0; i < 2; ++i)                                            \
            RV[i] = *(const u32x4*)(VTG + (size_t)(b * 1024 + h * 256 + slice * 64 + (tid >> 3) + 32 * i) * VTLD + tokpos0 + (tid & 7) * 8); \
        if (tid < 128) RE = EXPL[(size_t)(dir * 264 + cidx) * 512 + h * 128 + tid];              \
    } while (0)
#define SCAN_STORE(RQ, RK, RV, RE)                                                               \
    do {                                                                                         \
        __syncthreads();                                                                         \
        _Pragma("unroll") for (int i = 0; i < 4; ++i) {                                          \
            if (mode) *(u32x4*)(Qs + ((tid >> 4) + 16 * i) * 136 + (tid & 15) * 8) = RQ[i];      \
            *(u32x4*)(KTs + ((tid >> 3) + 32 * i) * 72 + (tid & 7) * 8) = RK[i];                 \
        }                                                                                        \
        _Pragma("unroll") for (int i = 0; i < 2; ++i) *(u32x4*)(Vs + ((tid >> 3) + 32 * i) * 72 + (tid & 7) * 8) = RV[i]; \
        if (tid < 128) { Es[tid] = RE; dprod *= RE; }                                            \
        __syncthreads();                                                                         \
    } while (0)
#define SCAN_COMPUTE(row0, stepcur)                                                              \
    do {                                                                                         \
        if (mode && ((stepcur) >= 4 || write_ctx)) {                                             \
            bf16x8 bs[4];                                                                        \
            _Pragma("unroll") for (int jj = 0; jj < 4; ++jj) bs[jj] = pack8(S[2 * jj][0], S[2 * jj][1], S[2 * jj][2], S[2 * jj][3], S[2 * jj + 1][0], S[2 * jj + 1][1], S[2 * jj + 1][2], S[2 * jj + 1][3]); \
            _Pragma("unroll") for (int mtt = 0; mtt < 4; ++mtt) {                                \
                f32x4 o = {0.f, 0.f, 0.f, 0.f};                                                  \
                _Pragma("unroll") for (int jj = 0; jj < 4; ++jj) {                               \
                    const bf16* qp = Qs + (16 * mtt + l16) * 136 + 32 * jj + 4 * g;              \
                    o = MFMA16(join4(*(const s16x4*)qp, *(const s16x4*)(qp + 16)), bs[jj], o);   \
                }                                                                                \
                _Pragma("unroll") for (int i = 0; i < 4; ++i) OUT[(size_t)((row0) + 16 * mtt + 4 * g + i) * 1024 + h * 256 + slice * 64 + 16 * w + l16] = f2bf(o[i]); \
            }                                                                                    \
        }                                                                                        \
        _Pragma("unroll") for (int ks = 0; ks < 2; ++ks) {                                       \
            const bf16x8 bv = *(const bf16x8*)(Vs + (16 * w + l16) * 72 + 32 * ks + 8 * g);      \
            _Pragma("unroll") for (int mt = 0; mt < 8; ++mt) { const bf16x8 ak = *(const bf16x8*)(KTs + (16 * mt + l16) * 72 + 32 * ks + 8 * g); S[mt] = MFMA16(ak, bv, S[mt]); } \
        }                                                                                        \
        _Pragma("unroll") for (int mt = 0; mt < 8; ++mt) { const f32x4 e = *(const f32x4*)(Es + 16 * mt + 4 * g); S[mt] = S[mt] * e; } \
    } while (0)
#pragma unroll
    for (int i = 0; i < 4; ++i) { rqA[i] = (u32x4){0u, 0u, 0u, 0u}; rqB[i] = (u32x4){0u, 0u, 0u, 0u}; }
    CHUNK_OF(s0); SCAN_ISSUE(rqA, rkA, rvA, reA); rowA = cidx * 64;
    if (s0 + 1 < s1) { CHUNK_OF(s0 + 1); SCAN_ISSUE(rqB, rkB, rvB, reB); rowB = cidx * 64; }
    for (int step = s0; step < s1; step += 2) {
        {
            SCAN_STORE(rqA, rkA, rvA, reA);
            const int row0 = rowA;
            if (step + 2 < s1) { CHUNK_OF(step + 2); SCAN_ISSUE(rqA, rkA, rvA, reA); rowA = cidx * 64; }
            SCAN_COMPUTE(row0, step);
        }
        if (step + 1 < s1) {
            SCAN_STORE(rqB, rkB, rvB, reB);
            const int row0 = rowB;
            if (step + 3 < s1) { CHUNK_OF(step + 3); SCAN_ISSUE(rqB, rkB, rvB, reB); rowB = cidx * 64; }
            SCAN_COMPUTE(row0, step + 1);
        }
    }
#undef CHUNK_OF
#undef SCAN_ISSUE
#undef SCAN_STORE
#undef SCAN_COMPUTE
    if (mode == 0) {
#pragma unroll
        for (int mt = 0; mt < 8; ++mt) *(f32x4*)(SLOC + ((((size_t)(cs * NSEG + seg) * 4 + w) * 8 + mt) * 64 + lane) * 4) = S[mt];
        if (tid < 128) DSEG[(size_t)(cs * NSEG + seg) * 128 + tid] = dprod;
    }
    __syncthreads();
}
DI void phase_gla_comb(const Params& p, int j, int nrows) {
    const int lane = tidx() & 63, gw = blockIdx.x * 4 + (tidx() >> 6), nw = gridDim.x * 4;
    const bf16* OI = (const bf16*)(p.ws + S_OI); const bf16* OF = (const bf16*)(p.ws + S_QKR); const bf16* OB = (const bf16*)(p.ws + S_OB);
    bf16* G = (bf16*)(p.ws + S_MIX);
    const float* hn = p.g_hn + j * 256 + (lane & 15) * 16;
    for (int row = gw; row < nrows; row += nw) {
        const size_t off = (size_t)row * 1024 + lane * 16;
        float o[16]; float ss = 0.f;
#pragma unroll
        for (int q = 0; q < 2; ++q) {
            const u32x4 a = *(const u32x4*)(OI + off + 8 * q), bb = *(const u32x4*)(OF + off + 8 * q), cc = *(const u32x4*)(OB + off + 8 * q);
#pragma unroll
            for (int e = 0; e < 4; ++e) {
                const float lo = bf2f((bf16)(a[e] & 0xffff)) + bf2f((bf16)(bb[e] & 0xffff)) + bf2f((bf16)(cc[e] & 0xffff));
                const float hi = bf2f((bf16)(a[e] >> 16)) + bf2f((bf16)(bb[e] >> 16)) + bf2f((bf16)(cc[e] >> 16));
                o[8 * q + 2 * e] = lo; o[8 * q + 2 * e + 1] = hi; ss += lo * lo + hi * hi;
            }
        }
        ss += __shfl_xor(ss, 1); ss += __shfl_xor(ss, 2); ss += __shfl_xor(ss, 4); ss += __shfl_xor(ss, 8);
        const float rs = rsqrtf(ss * (1.f / 256.f) + EPS);
#pragma unroll
        for (int q = 0; q < 2; ++q) {
            const u32x4 gg = *(const u32x4*)(G + off + 8 * q); u32x4 r;
#pragma unroll
            for (int e = 0; e < 4; ++e) {
                const float g0 = bf2f((bf16)(gg[e] & 0xffff)), g1 = bf2f((bf16)(gg[e] >> 16));
                r[e] = pack2(o[8 * q + 2 * e] * rs * hn[8 * q + 2 * e] * silu(g0), o[8 * q + 2 * e + 1] * rs * hn[8 * q + 2 * e + 1] * silu(g1));
            }
            *(u32x4*)(G + off + 8 * q) = r;
        }
    }
}

enum { K_PREP_A = 0, K_PREP_B, K_A_IN, K_A_ATT, K_OUT, K_LN1, K_UP, K_DOWN, K_LN2, K_G_IN, K_G_INTRA, K_G_SCAN, K_G_COMB, K_G_SCAN2 };
constexpr int NPHASES = 36;
DI void phase_decode(int ph, int& kind, int& layer) {
    if (ph < 2) { kind = ph; layer = 0; return; }
    ph -= 2; const int pair = ph / 17, r = ph - pair * 17;
    if (r < 7) { layer = 2 * pair; kind = r < 2 ? K_A_IN + r : K_OUT + (r - 2); }
    else {
        layer = 2 * pair + 1; const int q = r - 7;
        kind = q == 0 ? K_G_IN : q == 1 ? K_G_INTRA : q == 2 ? K_G_SCAN : q == 3 ? K_G_SCAN2 : q == 4 ? K_G_COMB : K_OUT + (q - 5);
    }
}
DI void run_phase(const Params& pin, int ph, unsigned char* lds) {
    Params p = pin;
    asm volatile("" : "+s"(p.ws));
    int kind, l; phase_decode(ph, kind, l);
    const int j = l >> 1; const bool need_ctx = l < 3; const int nrows = need_ctx ? TA : TL;
#ifdef ONLY_KIND
    if (kind != ONLY_KIND) return;
    kind = ONLY_KIND;
#endif
    switch (kind) {
    case K_PREP_A: phase_prep_a(p, lds); break;
    case K_PREP_B: phase_prep_b(p); break;
    case K_A_IN: phase_attn_in(p, j, lds); break;
    case K_A_ATT: for (int it = blockIdx.x; it < 1056; it += gridDim.x) attn_item(p, j, it, lds); break;
    case K_OUT: phase_gemm_y(p, (const bf16*)(p.ws + S_MIX), 1024, (const bf16*)(p.ws + OFF_WTS) + W_OUT, 1024, need_ctx, lds); break;
    case K_LN1: phase_ln(p, l, 0, nrows); break;
    case K_UP: phase_up(p, l, need_ctx, lds); break;
    case K_DOWN: phase_gemm_y(p, (const bf16*)(p.ws + S_A2), DFF, (const bf16*)(p.ws + OFF_WTS) + W_DOWN, DFF, need_ctx, lds); break;
    case K_LN2:
        phase_ln(p, l, 1, nrows);
        if (l < 3) { const int nc = conv_count(l + 1); for (int it = blockIdx.x; it < nc; it += gridDim.x) convert_item(p, l + 1, it, lds); }
        break;
    case K_G_IN: phase_gla_in(p, lds); break;
    case K_G_INTRA: for (int it = blockIdx.x; it < 264 * 4; it += gridDim.x) gla_intra_item(p, j, it, lds); break;
    case K_G_SCAN: for (int it = blockIdx.x; it < 64 * NSEG; it += gridDim.x) gla_scan_item(p, it, 0, need_ctx, lds); break;
    case K_G_SCAN2: for (int it = blockIdx.x; it < 64 * NSEG; it += gridDim.x) gla_scan_item(p, it, 1, need_ctx, lds); break;
    case K_G_COMB: phase_gla_comb(p, j, nrows); break;
    }
}

__global__ void __launch_bounds__(NTHREADS, 2) mega(Params p, int ph_lo, int ph_hi) {
    extern __shared__ __attribute__((aligned(16))) unsigned char lds[];
    volatile LAS unsigned* st = (volatile LAS unsigned*)(lds + LDS_BYTES);
    if (__builtin_amdgcn_workitem_id_x() == 0) { st[0] = 0u; st[1] = 0u; st[2] = 0u; st[3] = 0u; }
    __syncthreads();
    XcdBarrier xb = xcd_barrier_post((unsigned*)(p.ws + OFF_BAR), st);
    for (int ph = ph_lo; ph < ph_hi; ++ph) {
        run_phase(p, ph, lds);
#if PROBE_KIND >= 0
        { int kind, l; phase_decode(ph, kind, l); if (kind == PROBE_KIND) { xcd_barrier(xb); run_phase(p, ph, lds); } }
#endif
        if (ph + 1 < ph_hi) xcd_barrier(xb);
    }
}

extern "C" void kernel_launch(void* const* d_in, const int* in_sizes, int n_in, void* d_out, int out_size, void* d_ws, size_t ws_size, hipStream_t stream) {
    static int grid = 0;
    if (grid == 0) {
        if (n_in != 23 || ws_size < WS_END) { fprintf(stderr, "kernel_launch: need 23 inputs and %zu ws bytes; got %d, %zu\n", (size_t)WS_END, n_in, ws_size); grid = -1; return; }
        int dev = 0, cus = 0, per_cu = 0;
        (void)hipGetDevice(&dev);
        (void)hipDeviceGetAttribute(&cus, hipDeviceAttributeMultiprocessorCount, dev);
        if (hipFuncSetAttribute((const void*)mega, hipFuncAttributeMaxDynamicSharedMemorySize, LDS_BYTES + 16) != hipSuccess) { fprintf(stderr, "hipFuncSetAttribute failed\n"); grid = -1; return; }
        if (hipOccupancyMaxActiveBlocksPerMultiprocessor(&per_cu, (const void*)mega, NTHREADS, LDS_BYTES + 16) != hipSuccess || per_cu < 1) { fprintf(stderr, "occupancy query failed (%d)\n", per_cu); grid = -1; return; }
        if (per_cu > 2) per_cu = 2;
        grid = cus * per_cu;
        fprintf(stderr, "kernel_launch: cus %d per_cu %d grid %d ws %zu need %zu\n", cus, per_cu, grid, ws_size, (size_t)WS_END);
    }
    if (grid < 0) return;
    Params p{};
    const float** pp = (const float**)&p;
    for (int i = 0; i < 23; ++i) pp[i] = (const float*)d_in[i];
    p.out = (float*)d_out; p.ws = (unsigned char*)d_ws;
    (void)hipMemsetAsync((unsigned char*)d_ws + OFF_BAR, 0, 16384 + 8192, stream);
#if SINGLE_LAUNCH
    int lo = 0, hi = NPHASES;
    void* args[] = {&p, &lo, &hi};
    hipError_t e = hipLaunchCooperativeKernel((const void*)mega, dim3(grid), dim3(NTHREADS), args, LDS_BYTES + 16, stream);
    if (e != hipSuccess) fprintf(stderr, "cooperative launch failed: %s (grid %d)\n", hipGetErrorString(e), grid);
#else
    for (int ph = 0; ph < NPHASES; ++ph) hipLaunchKernelGGL(mega, dim3(grid), dim3(NTHREADS), LDS_BYTES + 16, stream, p, ph, ph + 1);
#endif
}
```
